# Optimizing an MI355X kernel written in HIP

```python
import jax, jax.numpy as jnp
from jax import lax
import numpy as np

D_MODEL = 1024
BATCH = 4
SEQ = 8192
DEPTH = 1
DEC_BATCH = 128
DEC_SEQ = 8
PAST_LEN = 8192
PAGE_SIZE = 128

D_MIX = D_MODEL
D_A = D_MIX // 2
HEAD_DIM_A = 64
N_HEADS_A = D_A // HEAD_DIM_A
DILATED_CONFIGS = ((128, 1), (512, 4), (2048, 16))
WINDOW_MAX = 2048
ATTN_BLOCK = 128
ATTN_SCALE = HEAD_DIM_A ** -0.5
NUM_BUCKETS = 32
REL_MAX_DIST = 2048
D_B = D_MIX - D_A
N_HEADS_B = 4
HEAD_V_B = D_B // N_HEADS_B
EXPAND_B = 128
D_F = N_HEADS_B * EXPAND_B
GLA_CHUNK = 64
IN_WIDTHS = (D_A, D_A, D_A, D_A, D_F, D_F, D_B, D_B)
D_IN = sum(IN_WIDTHS)
IN_SPLITS = [int(s) for s in np.cumsum(IN_WIDTHS)[:-1]]
ALPHA = (2.0 * DEPTH) ** 0.25
BETA = (8.0 * DEPTH) ** -0.25
NORM_EPS = 1e-5

kernel_name = "hymba_dilated_hgrn2_deepnorm_step"


def _rel_buckets(dist):
    max_exact = NUM_BUCKETS // 2
    d = np.maximum(dist, 1).astype(np.float32)
    large = max_exact + (np.log(d / max_exact) / np.log(REL_MAX_DIST / max_exact)
                         * (NUM_BUCKETS - max_exact)).astype(np.int32)
    large = np.minimum(large, NUM_BUCKETS - 1)
    return np.where(dist < max_exact, dist, large).astype(np.int32)


def _rel_bias(table, dist):
    return jnp.moveaxis(table.astype(jnp.float32)[_rel_buckets(dist)], -1, 0)


def _attend(q, k, v, bias, mask):
    s = jnp.einsum('...qhd,...khd->...hqk', q.astype(jnp.float32), k.astype(jnp.float32)) * ATTN_SCALE + bias
    s = jnp.where(mask, s, -jnp.inf)
    m = jnp.max(s, axis=-1, keepdims=True)
    p = jnp.exp(s - m)
    den = jnp.sum(p, axis=-1, keepdims=True)
    out = jnp.einsum('...hqk,...khd->...qhd', p / den, v.astype(jnp.float32))
    lse = jnp.swapaxes((m + jnp.log(den))[..., 0], -1, -2)
    return out, lse


def _combine_by_denominator(outs, lses):
    w = jax.nn.softmax(jnp.stack(lses, axis=0), axis=0)
    return jnp.sum(w[..., None] * jnp.stack(outs, axis=0), axis=0)


def _dilated_prompt_cfg(q, k, v, rel_bias, window, dil):
    B, T, H, D = q.shape
    L = T // dil
    W = window // dil
    BQ = ATTN_BLOCK
    P = (-L) % BQ
    Lp = L + P
    nb = Lp // BQ

    def to_blocks(a):
        a = a.reshape(B, L, dil, H, D).transpose(0, 2, 1, 3, 4)
        a = jnp.pad(a, ((0, 0), (0, 0), (P, 0), (0, 0), (0, 0)))
        return a.reshape(B, dil, nb, BQ, H, D)

    def band(a):
        prev = jnp.pad(a, ((0, 0), (0, 0), (1, 0), (0, 0), (0, 0), (0, 0)))[:, :, :-1]
        return jnp.concatenate([prev, a], axis=3)

    qb = to_blocks(q)
    kb = band(to_blocks(k))
    vb = band(to_blocks(v))
    i = np.arange(BQ)[:, None]
    j = np.arange(2 * BQ)[None, :]
    sub = BQ + i - j
    band_ok = (sub >= 0) & (sub <= W)
    key_sub = (np.arange(nb)[:, None] - 1) * BQ + np.arange(2 * BQ)[None, :]
    q_sub = np.arange(nb)[:, None] * BQ + np.arange(BQ)[None, :]
    mask = band_ok[None] & ((key_sub >= P)[:, None, :] | (q_sub < P)[:, :, None])
    bias = _rel_bias(rel_bias, dil * np.clip(sub, 0, None))
    out, lse = _attend(qb, kb, vb, bias, mask[:, None])
    out = out.reshape(B, dil, Lp, H, D)[:, :, P:].transpose(0, 2, 1, 3, 4).reshape(B, T, H, D)
    lse = lse.reshape(B, dil, Lp, H)[:, :, P:].transpose(0, 2, 1, 3).reshape(B, T, H)
    return out, lse


def _dilated_sample_cfg(q, k_ext, v_ext, rel_bias, window, dil):
    B, Tn, H, D = q.shape
    Tk = k_ext.shape[1]
    W = window // dil
    idx = (Tk - Tn) + np.arange(Tn)[:, None] - dil * np.arange(W + 1)[None, :]
    valid = idx >= 0
    gidx = np.maximum(idx, 0)
    kg = k_ext[:, gidx]
    vg = v_ext[:, gidx]
    bias = _rel_bias(rel_bias, dil * np.arange(W + 1)[None, :])
    out, lse = _attend(q[:, :, None], kg, vg, bias, valid[:, None, None, :])
    return out[:, :, 0], lse[:, :, 0]


def _gla_chunked(q, k, v, g, S0, chunk):
    B, T, H, K = q.shape
    V = v.shape[-1]

    def chunks(a):
        return a.reshape(B, T // chunk, chunk, H, a.shape[-1]).transpose(1, 0, 3, 2, 4)

    causal = jnp.tril(jnp.ones((chunk, chunk), dtype=bool))

    def step(S, inp):
        qc, kc, vc, gc = inp
        b = jnp.cumsum(gc, axis=2)
        inter = jnp.einsum('bhck,bhkv->bhcv', qc * jnp.exp(b), S)
        diff = b[:, :, :, None, :] - b[:, :, None, :, :]
        decay = jnp.exp(jnp.where(causal[:, :, None], diff, -jnp.inf))
        A = jnp.einsum('bhtk,bhsk,bhtsk->bhts', qc, kc, decay)
        intra = jnp.einsum('bhts,bhsv->bhtv', A, vc)
        bC = b[:, :, -1]
        S_new = jnp.exp(bC)[..., None] * S + jnp.einsum(
            'bhsk,bhsv->bhkv', kc * jnp.exp(bC[:, :, None] - b), vc)
        return S_new, inter + intra

    S, o = lax.scan(step, S0, (chunks(q), chunks(k), chunks(v), chunks(g)))
    o = o.transpose(1, 0, 3, 2, 4).reshape(B, T, H, V)
    return o, S


def _hgrn2(qb, fb, ib, S0, lb, chunk):
    B, T, _ = qb.shape
    q = jax.nn.silu(qb.astype(jnp.float32)).reshape(B, T, N_HEADS_B, EXPAND_B) * EXPAND_B ** -0.5
    f = lb + (1.0 - lb) * jax.nn.sigmoid(fb.astype(jnp.float32))
    k = (1.0 - f).reshape(B, T, N_HEADS_B, EXPAND_B)
    g = jnp.log(f).reshape(B, T, N_HEADS_B, EXPAND_B)
    v = ib.astype(jnp.float32).reshape(B, T, N_HEADS_B, HEAD_V_B)
    return _gla_chunked(q, k, v, g, S0.astype(jnp.float32), chunk)


def _project(x, w_in):
    h = jnp.einsum('btd,de->bte', x, w_in)
    return jnp.split(h, IN_SPLITS, axis=-1)


def _heads_a(a):
    B, T, _ = a.shape
    return a.reshape(B, T, N_HEADS_A, HEAD_DIM_A)


def _merge(x, attn, ga, o_b, gb, w_out, norm_g, ln_g, ln_b):
    B, T, _ = x.shape
    a_out = attn.reshape(B, T, D_A).astype(x.dtype) * jax.nn.silu(ga)
    ms = jnp.mean(jnp.square(o_b), axis=-1, keepdims=True)
    o_n = o_b * lax.rsqrt(ms + NORM_EPS) * norm_g.astype(jnp.float32)
    b_out = o_n.reshape(B, T, D_B).astype(x.dtype) * jax.nn.silu(gb)
    mix = jnp.concatenate([a_out, b_out], axis=-1)
    z = (ALPHA * x + jnp.einsum('bte,ed->btd', mix, w_out)).astype(jnp.float32)
    mu = jnp.mean(z, axis=-1, keepdims=True)
    var = jnp.mean(jnp.square(z - mu), axis=-1, keepdims=True)
    y = (z - mu) * lax.rsqrt(var + NORM_EPS) * ln_g.astype(jnp.float32) + ln_b.astype(jnp.float32)
    return y.astype(x.dtype)


def _prompt_layer(x, w_in, w_out, rel_bias, lb, norm_g, ln_g, ln_b):
    B, T, _ = x.shape
    qa, ka, va, ga, qb, fb, ib, gb = _project(x, w_in)
    qa, ka, va = _heads_a(qa), _heads_a(ka), _heads_a(va)
    outs, lses = [], []
    for window, dil in DILATED_CONFIGS:
        o, l = _dilated_prompt_cfg(qa, ka, va, rel_bias, window, dil)
        outs.append(o)
        lses.append(l)
    attn = _combine_by_denominator(outs, lses)
    S0 = jnp.zeros((B, N_HEADS_B, EXPAND_B, HEAD_V_B), jnp.float32)
    o_b, S = _hgrn2(qb, fb, ib, S0, lb, min(GLA_CHUNK, T))
    y = _merge(x, attn, ga, o_b, gb, w_out, norm_g, ln_g, ln_b)
    keep = min(WINDOW_MAX, T)
    return y, ka[:, T - keep:], va[:, T - keep:], S


def _sample_layer(x, k_past, v_past, S0, w_in, w_out, rel_bias, lb, norm_g, ln_g, ln_b):
    B, T, _ = x.shape
    qa, ka, va, ga, qb, fb, ib, gb = _project(x, w_in)
    qa, ka, va = _heads_a(qa), _heads_a(ka), _heads_a(va)
    k_ext = jnp.concatenate([k_past, ka.astype(k_past.dtype)], axis=1)
    v_ext = jnp.concatenate([v_past, va.astype(v_past.dtype)], axis=1)
    outs, lses = [], []
    for window, dil in DILATED_CONFIGS:
        o, l = _dilated_sample_cfg(qa, k_ext, v_ext, rel_bias, window, dil)
        outs.append(o)
        lses.append(l)
    attn = _combine_by_denominator(outs, lses)
    o_b, S = _hgrn2(qb, fb, ib, S0, lb, T)
    y = _merge(x, attn, ga, o_b, gb, w_out, norm_g, ln_g, ln_b)
    wb = k_past.shape[1]
    return y, k_ext[:, T:T + wb], v_ext[:, T:T + wb], S.astype(S0.dtype)


def setup_inputs(seed: int = 0) -> dict:
    key = jax.random.key(seed)
    ks = jax.random.split(key, 12)
    win_buf = min(WINDOW_MAX, PAST_LEN)
    x_prompt = jax.random.normal(ks[0], (BATCH, SEQ, D_MODEL), jnp.float32)
    x_sample = jax.random.normal(ks[1], (DEC_BATCH, DEC_SEQ, D_MODEL), jnp.float32)
    cache_k = jax.random.normal(ks[2], (DEPTH, DEC_BATCH, win_buf, N_HEADS_A, HEAD_DIM_A), jnp.float32)
    cache_v = jax.random.normal(ks[3], (DEPTH, DEC_BATCH, win_buf, N_HEADS_A, HEAD_DIM_A), jnp.float32) * BETA
    state_hgrn = jax.random.normal(ks[4], (DEPTH, DEC_BATCH, N_HEADS_B, EXPAND_B, HEAD_V_B), jnp.float32) * 0.5
    col_scale = jnp.ones((D_IN,), jnp.float32)
    col_scale = col_scale.at[2 * D_A:3 * D_A].set(BETA)
    col_scale = col_scale.at[4 * D_A + 2 * D_F:4 * D_A + 2 * D_F + D_B].set(BETA)
    w_in = jax.random.normal(ks[5], (DEPTH, D_MODEL, D_IN), jnp.float32) * (D_MODEL ** -0.5) * col_scale
    w_out = jax.random.normal(ks[6], (DEPTH, D_MIX, D_MODEL), jnp.float32) * (D_MIX ** -0.5) * BETA
    rel_bias = jax.random.normal(ks[7], (NUM_BUCKETS, N_HEADS_A), jnp.float32) * 0.5
    lb_param = jax.random.normal(ks[8], (DEPTH + 1, D_F), jnp.float32) * 0.5
    hgrn_norm_g = 1.0 + 0.05 * jax.random.normal(ks[9], (DEPTH, HEAD_V_B), jnp.float32)
    ln_g = 1.0 + 0.05 * jax.random.normal(ks[10], (DEPTH, D_MODEL), jnp.float32)
    ln_b = 0.02 * jax.random.normal(ks[11], (DEPTH, D_MODEL), jnp.float32)
    return {"x_prompt": x_prompt, "x_sample": x_sample, "cache_k": cache_k, "cache_v": cache_v,
            "state_hgrn": state_hgrn, "w_in": w_in, "w_out": w_out, "rel_bias": rel_bias,
            "lb_param": lb_param, "hgrn_norm_g": hgrn_norm_g, "ln_g": ln_g, "ln_b": ln_b}


def reference(x_prompt, x_sample, cache_k, cache_v, state_hgrn, w_in, w_out, rel_bias,
              lb_param, hgrn_norm_g, ln_g, ln_b):
    lb_all = jnp.cumsum(jax.nn.softmax(lb_param.astype(jnp.float32), axis=0), axis=0)
    yp, ys = x_prompt, x_sample
    kp_l, vp_l, sp_l, ks_l, vs_l, ss_l = [], [], [], [], [], []
    for l in range(DEPTH):
        yp, kp, vp, sp = _prompt_layer(yp, w_in[l], w_out[l], rel_bias, lb_all[l],
                                       hgrn_norm_g[l], ln_g[l], ln_b[l])
        ys, k_s, v_s, s_s = _sample_layer(ys, cache_k[l], cache_v[l], state_hgrn[l], w_in[l], w_out[l],
                                          rel_bias, lb_all[l], hgrn_norm_g[l], ln_g[l], ln_b[l])
        kp_l.append(kp)
        vp_l.append(vp)
        sp_l.append(sp)
        ks_l.append(k_s)
        vs_l.append(v_s)
        ss_l.append(s_s)
    return (yp, ys, jnp.stack(kp_l), jnp.stack(vp_l), jnp.stack(ks_l), jnp.stack(vs_l),
            jnp.stack(sp_l), jnp.stack(ss_l))
```

```cpp
#include <hip/hip_runtime.h>
#include <cmath>
#ifndef HD
#define HD __host__ __device__ __forceinline__
#endif
#ifndef CFG_BATCH
#define CFG_BATCH 4
#endif
#ifndef CFG_SEQ
#define CFG_SEQ 8192
#endif
#ifndef CFG_DEC_BATCH
#define CFG_DEC_BATCH 128
#endif
namespace nv {
constexpr int D_MODEL = 1024, BATCH = CFG_BATCH, SEQ = CFG_SEQ, DEC_BATCH = CFG_DEC_BATCH, DEC_SEQ = 8;
constexpr int D_A = 512, HDA = 64, NHA = 8, D_B = 512, NHB = 4, HVB = 128, EXB = 128, D_F = 512, D_IN = 4096, D_MIX = 1024;
constexpr int WIN = 2048;
constexpr int MP = BATCH * SEQ;
constexpr int MS = DEC_BATCH * DEC_SEQ;
constexpr int MT = MP + MS;
constexpr float ATTN_SCALE = 0.125f;
constexpr float ALPHA = 1.189207115002721f;
constexpr float NORM_EPS = 1e-5f;
constexpr int C_QA = 0, C_KA = 512, C_VA = 1024, C_GA = 1536, C_QB = 2048, C_FB = 2560, C_IB = 3072, C_GB = 3584;

HD int rel_bucket(int d) {
    if (d < 16) return d;
    const int thr[15] = {22, 30, 40, 54, 73, 99, 134, 182, 246, 332, 450, 609, 825, 1117, 1513};
    int b = 16;
    _Pragma("unroll") for (int i = 0; i < 15; ++i) b += (d >= thr[i]) ? 1 : 0;
    return b;
}
HD float silu_f(float x) { return x / (1.0f + expf(-x)); }
HD float sigmoid_f(float x) { return 1.0f / (1.0f + expf(-x)); }

HD void attn_prompt_elem(int idx, const float* h, const float* rel_bias, float* attn  ) {
    const int hh = idx % NHA; const int t = (idx / NHA) % SEQ; const int b = idx / (NHA * SEQ);
    const float* qrow = h + (size_t)(b * SEQ + t) * D_IN + C_QA + hh * HDA;
    float q[HDA];
    _Pragma("unroll") for (int d = 0; d < HDA; ++d) q[d] = qrow[d];
    float m = -INFINITY, l = 0.f; float acc[HDA];
    _Pragma("unroll") for (int d = 0; d < HDA; ++d) acc[d] = 0.f;
    for (int c = 0; c < 3; ++c) {
        const int dil = (c == 0) ? 1 : (c == 1 ? 4 : 16);
        for (int j = 0; j <= 128; ++j) {
            const int tk = t - dil * j;
            if (tk < 0) break;
            const float* krow = h + (size_t)(b * SEQ + tk) * D_IN + C_KA + hh * HDA;
            const float* vrow = h + (size_t)(b * SEQ + tk) * D_IN + C_VA + hh * HDA;
            float s = 0.f;
            _Pragma("unroll") for (int d = 0; d < HDA; ++d) s += q[d] * krow[d];
            s = s * ATTN_SCALE + rel_bias[rel_bucket(dil * j) * NHA + hh];
            const float mn = fmaxf(m, s);
            const float corr = expf(m - mn), p = expf(s - mn);
            l = l * corr + p;
            _Pragma("unroll") for (int d = 0; d < HDA; ++d) acc[d] = acc[d] * corr + p * vrow[d];
            m = mn;
        }
    }
    const float inv = 1.0f / l;
    float* o = attn + (size_t)(b * SEQ + t) * D_A + hh * HDA;
    _Pragma("unroll") for (int d = 0; d < HDA; ++d) o[d] = acc[d] * inv;
}

HD void attn_sample_elem(int idx, const float* h, const float* cache_k, const float* cache_v, const float* rel_bias, float* attn) {
    const int hh = idx % NHA; const int t = (idx / NHA) % DEC_SEQ; const int b = idx / (NHA * DEC_SEQ);
    const int row = MP + b * DEC_SEQ + t;
    const float* qrow = h + (size_t)row * D_IN + C_QA + hh * HDA;
    float q[HDA];
    _Pragma("unroll") for (int d = 0; d < HDA; ++d) q[d] = qrow[d];
    float m = -INFINITY, l = 0.f; float acc[HDA];
    _Pragma("unroll") for (int d = 0; d < HDA; ++d) acc[d] = 0.f;
    for (int c = 0; c < 3; ++c) {
        const int dil = (c == 0) ? 1 : (c == 1 ? 4 : 16);
        for (int j = 0; j <= 128; ++j) {
            const int e = WIN + t - dil * j;
            if (e < 0) break;
            const float *krow, *vrow;
            if (e < WIN) { krow = cache_k + ((size_t)(b * WIN + e) * NHA + hh) * HDA; vrow = cache_v + ((size_t)(b * WIN + e) * NHA + hh) * HDA; }
            else { const int r2 = MP + b * DEC_SEQ + (e - WIN); krow = h + (size_t)r2 * D_IN + C_KA + hh * HDA; vrow = h + (size_t)r2 * D_IN + C_VA + hh * HDA; }
            float s = 0.f;
            _Pragma("unroll") for (int d = 0; d < HDA; ++d) s += q[d] * krow[d];
            s = s * ATTN_SCALE + rel_bias[rel_bucket(dil * j) * NHA + hh];
            const float mn = fmaxf(m, s);
            const float corr = expf(m - mn), p = expf(s - mn);
            l = l * corr + p;
            _Pragma("unroll") for (int d = 0; d < HDA; ++d) acc[d] = acc[d] * corr + p * vrow[d];
            m = mn;
        }
    }
    const float inv = 1.0f / l;
    float* o = attn + (size_t)row * D_A + hh * HDA;
    _Pragma("unroll") for (int d = 0; d < HDA; ++d) o[d] = acc[d] * inv;
}

HD void lb_elem(int idx, const float* lb_param, float* lbv) {
    const float a0 = lb_param[idx], a1 = lb_param[D_F + idx];
    lbv[idx] = 1.0f / (1.0f + expf(a1 - a0));
}
HD void hgrn_elem(int idx, int T, int row0, const float* h, const float* lbv, const float* S0, float* Sout, float* og) {
    const int v = idx % HVB; const int hh = (idx / HVB) % NHB; const int b = idx / (HVB * NHB);
    float S[EXB];
#pragma unroll
    for (int k = 0; k < EXB; ++k) S[k] = S0 ? S0[(((size_t)b * NHB + hh) * EXB + k) * HVB + v] : 0.f;
    for (int t = 0; t < T; ++t) {
        const float* hr = h + (size_t)(row0 + b * T + t) * D_IN;
        const float iv = hr[C_IB + hh * HVB + v];
        float o = 0.f;
#pragma unroll
        for (int k = 0; k < EXB; ++k) {
            const float lbk = lbv[hh * EXB + k];
            const float f = lbk + (1.0f - lbk) * sigmoid_f(hr[C_FB + hh * EXB + k]);
            const float qq = silu_f(hr[C_QB + hh * EXB + k]) * 0.08838834764831845f;
            S[k] = f * S[k] + (1.0f - f) * iv;
            o += S[k] * qq;
        }
        og[(size_t)(row0 + b * T + t) * D_B + hh * HVB + v] = o;
    }
#pragma unroll
    for (int k = 0; k < EXB; ++k) Sout[(((size_t)b * NHB + hh) * EXB + k) * HVB + v] = S[k];
}

HD void mix_elem(size_t idx, const float* h, const float* attn, const float* og, const float* norm_g, float* mix) {
    const int e = (int)(idx % D_MIX); const size_t row = idx / D_MIX;
    float r;
    if (e < D_A) r = attn[row * D_A + e] * silu_f(h[row * D_IN + C_GA + e]);
    else {
        const int eb = e - D_A, hh = eb / HVB, v = eb % HVB;
        const float* o = og + row * D_B + hh * HVB;
        float ms = 0.f;
        for (int i = 0; i < HVB; ++i) ms += o[i] * o[i];
        ms *= (1.0f / HVB);
        r = o[v] / sqrtf(ms + NORM_EPS) * norm_g[v] * silu_f(h[row * D_IN + C_GB + eb]);
    }
    mix[idx] = r;
}

HD void ln_row(size_t row, const float* x, const float* ln_g, const float* ln_b, float* y) {
    float* z = y + row * D_MODEL; const float* xr = x + row * D_MODEL;
    float mu = 0.f;
    for (int i = 0; i < D_MODEL; ++i) { z[i] += ALPHA * xr[i]; mu += z[i]; }
    mu *= (1.0f / D_MODEL);
    float var = 0.f;
    for (int i = 0; i < D_MODEL; ++i) { const float d = z[i] - mu; var += d * d; }
    var *= (1.0f / D_MODEL);
    const float rs = 1.0f / sqrtf(var + NORM_EPS);
    for (int i = 0; i < D_MODEL; ++i) z[i] = (z[i] - mu) * rs * ln_g[i] + ln_b[i];
}

HD void win_prompt_elem(size_t idx, const float* h, float* kw, float* vw) {
    const int c = (int)(idx % D_A); const int i = (int)((idx / D_A) % WIN); const int b = (int)(idx / ((size_t)D_A * WIN));
    const size_t row = (size_t)b * SEQ + (SEQ - WIN) + i;
    kw[idx] = h[row * D_IN + C_KA + c]; vw[idx] = h[row * D_IN + C_VA + c];
}
HD void win_sample_elem(size_t idx, const float* h, const float* cache_k, const float* cache_v, float* kw, float* vw) {
    const int c = (int)(idx % D_A); const int i = (int)((idx / D_A) % WIN); const int b = (int)(idx / ((size_t)D_A * WIN));
    const int e = i + DEC_SEQ;
    if (e < WIN) { kw[idx] = cache_k[((size_t)b * WIN + e) * D_A + c]; vw[idx] = cache_v[((size_t)b * WIN + e) * D_A + c]; }
    else { const size_t row = (size_t)MP + b * DEC_SEQ + (e - WIN); kw[idx] = h[row * D_IN + C_KA + c]; vw[idx] = h[row * D_IN + C_VA + c]; }
}
}
using namespace nv;
__global__ void __launch_bounds__(256) k_gemm_naive(const float* __restrict__ A, const float* __restrict__ B, float* __restrict__ C, int M, int N, int K) {
    __shared__ float As[16][64 + 4];
    __shared__ float Bs[16][64 + 4];
    const int tx = threadIdx.x & 15, ty = threadIdx.x >> 4;
    const int m0 = blockIdx.y * 64, n0 = blockIdx.x * 64;
    float acc[4][4];
#pragma unroll
    for (int i = 0; i < 4; ++i)
#pragma unroll
        for (int j = 0; j < 4; ++j) acc[i][j] = 0.f;
    for (int k0 = 0; k0 < K; k0 += 16) {
#pragma unroll
        for (int i = 0; i < 4; ++i) { const int e = threadIdx.x + i * 256; const int r = e >> 4, c = e & 15; As[c][r] = A[(size_t)(m0 + r) * K + k0 + c]; }
#pragma unroll
        for (int i = 0; i < 4; ++i) { const int e = threadIdx.x + i * 256; const int r = e >> 6, c = e & 63; Bs[r][c] = B[(size_t)(k0 + r) * N + n0 + c]; }
        __syncthreads();
#pragma unroll
        for (int kk = 0; kk < 16; ++kk) {
            float a[4], b[4];
#pragma unroll
            for (int i = 0; i < 4; ++i) { a[i] = As[kk][ty * 4 + i]; b[i] = Bs[kk][tx * 4 + i]; }
#pragma unroll
            for (int i = 0; i < 4; ++i)
#pragma unroll
                for (int j = 0; j < 4; ++j) acc[i][j] += a[i] * b[j];
        }
        __syncthreads();
    }
#pragma unroll
    for (int i = 0; i < 4; ++i)
#pragma unroll
        for (int j = 0; j < 4; ++j) C[(size_t)(m0 + ty * 4 + i) * N + n0 + tx * 4 + j] = acc[i][j];
}
__global__ void __launch_bounds__(256) k_attn_prompt(const float* h, const float* rel_bias, float* attn) {
    const int i = blockIdx.x * blockDim.x + threadIdx.x; if (i < BATCH * SEQ * NHA) attn_prompt_elem(i, h, rel_bias, attn);
}
__global__ void __launch_bounds__(256) k_attn_sample(const float* h, const float* ck, const float* cv, const float* rel_bias, float* attn) {
    const int i = blockIdx.x * blockDim.x + threadIdx.x; if (i < DEC_BATCH * DEC_SEQ * NHA) attn_sample_elem(i, h, ck, cv, rel_bias, attn);
}
__global__ void k_lb(const float* lb_param, float* lbv) { const int i = blockIdx.x * blockDim.x + threadIdx.x; if (i < 512) lb_elem(i, lb_param, lbv); }
__global__ void __launch_bounds__(128) k_hgrn(int nthreads, int T, int row0, const float* h, const float* lbv, const float* S0, float* Sout, float* og) {
    const int i = blockIdx.x * blockDim.x + threadIdx.x; if (i < nthreads) hgrn_elem(i, T, row0, h, lbv, S0, Sout, og);
}
__global__ void k_mix(const float* h, const float* attn, const float* og, const float* norm_g, float* mix) {
    size_t i = (size_t)blockIdx.x * blockDim.x + threadIdx.x; const size_t st = (size_t)gridDim.x * blockDim.x;
    for (; i < (size_t)MT * D_MIX; i += st) mix_elem(i, h, attn, og, norm_g, mix);
}
__global__ void k_ln(int nrows, const float* x, const float* ln_g, const float* ln_b, float* y) {
    const int i = blockIdx.x * blockDim.x + threadIdx.x; if (i < nrows) ln_row(i, x, ln_g, ln_b, y);
}
__global__ void k_win_prompt(const float* h, float* kw, float* vw) {
    size_t i = (size_t)blockIdx.x * blockDim.x + threadIdx.x; const size_t st = (size_t)gridDim.x * blockDim.x;
    for (; i < (size_t)BATCH * WIN * D_A; i += st) win_prompt_elem(i, h, kw, vw);
}
__global__ void k_win_sample(const float* h, const float* ck, const float* cv, float* kw, float* vw) {
    size_t i = (size_t)blockIdx.x * blockDim.x + threadIdx.x; const size_t st = (size_t)gridDim.x * blockDim.x;
    for (; i < (size_t)DEC_BATCH * WIN * D_A; i += st) win_sample_elem(i, h, ck, cv, kw, vw);
}

extern "C" void kernel_launch(void* const* d_in, const int* in_sizes, int n_in, void* d_out, int out_size, void* d_ws, size_t ws_size, hipStream_t stream) {
    const float* x_prompt = (const float*)d_in[0]; const float* x_sample = (const float*)d_in[1];
    const float* cache_k = (const float*)d_in[2]; const float* cache_v = (const float*)d_in[3]; const float* state = (const float*)d_in[4];
    const float* w_in = (const float*)d_in[5]; const float* w_out = (const float*)d_in[6]; const float* rel_bias = (const float*)d_in[7];
    const float* lb_param = (const float*)d_in[8]; const float* norm_g = (const float*)d_in[9]; const float* ln_g = (const float*)d_in[10]; const float* ln_b = (const float*)d_in[11];
    float* out = (float*)d_out;
    float* y = out;
    float* kwp = out + (size_t)MT * D_MODEL; float* vwp = kwp + (size_t)BATCH * WIN * D_A;
    float* kws = vwp + (size_t)BATCH * WIN * D_A; float* vws = kws + (size_t)DEC_BATCH * WIN * D_A;
    float* sp = vws + (size_t)DEC_BATCH * WIN * D_A; float* ss = sp + (size_t)BATCH * NHB * EXB * HVB;
    float* ws = (float*)d_ws;
    float* h = ws; float* attn = h + (size_t)MT * D_IN; float* og = attn + (size_t)MT * D_A; float* mix = og + (size_t)MT * D_B; float* lbv = mix + (size_t)MT * D_MIX;
    if ((size_t)((lbv + 512) - ws) * 4 > ws_size) return;
    k_gemm_naive<<<dim3(D_IN / 64, MP / 64), 256, 0, stream>>>(x_prompt, w_in, h, MP, D_IN, D_MODEL);
    k_gemm_naive<<<dim3(D_IN / 64, MS / 64), 256, 0, stream>>>(x_sample, w_in, h + (size_t)MP * D_IN, MS, D_IN, D_MODEL);
    k_lb<<<2, 256, 0, stream>>>(lb_param, lbv);
    k_attn_prompt<<<BATCH * SEQ * NHA / 256, 256, 0, stream>>>(h, rel_bias, attn);
    k_attn_sample<<<DEC_BATCH * DEC_SEQ * NHA / 256, 256, 0, stream>>>(h, cache_k, cache_v, rel_bias, attn);
    k_hgrn<<<BATCH * NHB, 128, 0, stream>>>(BATCH * NHB * HVB, SEQ, 0, h, lbv, nullptr, sp, og);
    k_hgrn<<<DEC_BATCH * NHB, 128, 0, stream>>>(DEC_BATCH * NHB * HVB, DEC_SEQ, MP, h, lbv, state, ss, og);
    k_mix<<<8192, 256, 0, stream>>>(h, attn, og, norm_g, mix);
    k_gemm_naive<<<dim3(D_MODEL / 64, MT / 64), 256, 0, stream>>>(mix, w_out, y, MT, D_MODEL, D_MIX);
    k_ln<<<MP / 256, 256, 0, stream>>>(MP, x_prompt, ln_g, ln_b, y);
    k_ln<<<MS / 256, 256, 0, stream>>>(MS, x_sample, ln_g, ln_b, y + (size_t)MP * D_MODEL);
    k_win_prompt<<<4096, 256, 0, stream>>>(h, kwp, vwp);
    k_win_sample<<<8192, 256, 0, stream>>>(h, cache_k, cache_v, kws, vws);
}
```

```cpp
#include <hip/hip_runtime.h>
#include <cstdio>
#include <cstdint>
#include <cmath>
#define MK_N_LAUNCHES 1
namespace pg8 {
#define PG8_LAS __attribute__((address_space(3)))
typedef unsigned short bf16_t;
typedef short bf16x8 __attribute__((ext_vector_type(8)));
typedef float f32x4 __attribute__((ext_vector_type(4)));
typedef unsigned u32x4 __attribute__((ext_vector_type(4)));
constexpr int BM = 256, BK = 64, HALF = 128, HTB = HALF * BK * 2  , STAGE_BYTES = 8 * HTB, NXCD = 8, WGM = 8;

__host__ __device__ __forceinline__ int lds_byte(int r, int c) { const int st = (r >> 4) * 2 + (c >> 5), rr = r & 15, cc = c & 31, ob = rr * 64 + cc * 2; return st * 1024 + (ob ^ (((ob >> 9) & 1) << 5)); }
__host__ __device__ __forceinline__ void stage_rc(int b, int& R, int& C) { const int st = b / 1024, sb = b % 1024, swz = sb ^ (((sb >> 9) & 1) << 5); R = (st >> 1) * 16 + swz / 64; C = (st & 1) * 32 + (swz % 64) / 2; }
__host__ __device__ __forceinline__ int perm32(int rho) { const int n = rho >> 4, i = rho & 15; return 8 * (i >> 2) + 4 * n + (i & 3); }

struct Unit { int pm, pn; };
struct Gemm { const bf16_t* A; const bf16_t* Bt; int M, N, K; };

struct StaticOrder {
    int nM, nN, nwg, G, c;
    __host__ __device__ void init(int M, int N, int G_, int c_) { nM = M / BM; nN = N / BM; nwg = nM * nN; G = G_; c = c_; }
    __host__ __device__ bool next(int i, Unit& u) const {
        const long L = (long)i * G + c; if (L >= nwg) return false;
        int wgid = (int)L; { const int q = nwg / NXCD, r = nwg % NXCD, xcd = wgid % NXCD, off = wgid / NXCD; wgid = (xcd < r ? xcd * (q + 1) : r * (q + 1) + (xcd - r) * q) + off; }
        const int nig = WGM * nN, gid = wgid / nig, fm = gid * WGM, gsz = (nM - fm) < WGM ? (nM - fm) : WGM;
        u.pm = fm + ((wgid % nig) % gsz); u.pn = (wgid % nig) / gsz; return true;
    }
    __device__ __forceinline__ void a_ready(const Unit&) const {}
    __device__ __forceinline__ void done(const Unit&) const {}
};

__device__ __forceinline__ unsigned cvt_pk_bf16(float lo, float hi) { unsigned r; asm volatile("v_cvt_pk_bf16_f32 %0, %1, %2" : "=v"(r) : "v"(lo), "v"(hi)); return r; }
typedef float f32x2 __attribute__((ext_vector_type(2)));
__device__ __forceinline__ f32x2 gelu_pk(f32x2 v) {
    const f32x2 av = __builtin_elementwise_abs(v), d = av * 0.2316418882f + 1.0f;
    f32x2 t; t.x = __builtin_amdgcn_rcpf(d.x); t.y = __builtin_amdgcn_rcpf(d.y);
    f32x2 q = t * 0.5307027145f + (-0.7265760135f); q = q * t + 0.7107068705f; q = q * t + (-0.142248368f); q = q * t + 0.127414796f; q = q * t;
    const f32x2 s = (v * v) * (-0.72134752044f);
    f32x2 e; e.x = __builtin_amdgcn_exp2f(s.x); e.y = __builtin_amdgcn_exp2f(s.y);
    const f32x2 m = v * (q * e), r = v - m;
    f32x2 o; o.x = v.x < 0.f ? m.x : r.x; o.y = v.y < 0.f ? m.y : r.y; return o;
}

template <int ACT  > struct EpiBf16 {
    static constexpr bool PERM = true, AFTER_DRAIN = false; static_assert(ACT == 0 || ACT == 1, "EpiBf16: ACT is 0 (none) or 1 (gelu_pk)");
    bf16_t* O; int ldc; const float* bias; int split_cols; size_t split_stride; float scale0;
    __device__ __forceinline__ void operator()(const f32x4 (&acc)[2][2][4][2], const Unit& u, int wr, int wc, int fr, int fq) const {
        const int row0 = u.pm * BM + wr * 64 + fr; int colt = u.pn * BM; bf16_t* base = O;
        float sc = 1.f; if (split_cols) { const int t = colt / split_cols; base += (size_t)t * split_stride; colt -= t * split_cols; if (t == 0) sc = scale0; }
        const int col0 = colt + wc * 32 + 8 * fq, bcol0 = u.pn * BM + wc * 32 + 8 * fq;
        f32x4 bv[2][2];
#pragma unroll
        for (int bj = 0; bj < 2; ++bj)
#pragma unroll
            for (int n = 0; n < 2; ++n) bv[bj][n] = bias ? *(const f32x4*)(bias + bcol0 + bj * HALF + 4 * n) : (f32x4){0.f, 0.f, 0.f, 0.f};
#pragma unroll
        for (int ai = 0; ai < 2; ++ai)
#pragma unroll
            for (int m = 0; m < 4; ++m) { bf16_t* rowp = base + (size_t)(row0 + ai * HALF + m * 16) * ldc + col0;
#pragma unroll
                for (int bj = 0; bj < 2; ++bj) { f32x4 v0 = acc[ai][bj][m][0] + bv[bj][0], v1 = acc[ai][bj][m][1] + bv[bj][1];
                    if (ACT == 1) { f32x2 a = gelu_pk((f32x2){v0[0], v0[1]}), b = gelu_pk((f32x2){v0[2], v0[3]}), c = gelu_pk((f32x2){v1[0], v1[1]}), d = gelu_pk((f32x2){v1[2], v1[3]});
                        v0 = (f32x4){a.x, a.y, b.x, b.y}; v1 = (f32x4){c.x, c.y, d.x, d.y}; }
                    v0 = v0 * sc; v1 = v1 * sc; u32x4 w; w.x = cvt_pk_bf16(v0[0], v0[1]); w.y = cvt_pk_bf16(v0[2], v0[3]); w.z = cvt_pk_bf16(v1[0], v1[1]); w.w = cvt_pk_bf16(v1[2], v1[3]);
                    *(u32x4*)(rowp + bj * HALF) = w; } }
    }
};

struct PanelStats {
    unsigned* xbuf;
    unsigned* cnt;
    unsigned* tmo;
    int ntn; float eps;
    unsigned code;
    __device__ __forceinline__ bool run(const f32x4 (&v)[2][2][4][2], const Unit& u, int wr, int wc, int fr, int fq, PG8_LAS unsigned char* lds, int wid, int lane) const {
        typedef float f32x2v __attribute__((ext_vector_type(2)));
        PG8_LAS f32x2v* P = (PG8_LAS f32x2v*)lds;
        PG8_LAS f32x2v* S = (PG8_LAS f32x2v*)(lds + 8192);
        PG8_LAS unsigned* flag = (PG8_LAS unsigned*)(lds + 8192 + 2048);
#pragma unroll
        for (int ai = 0; ai < 2; ++ai)
#pragma unroll
            for (int m = 0; m < 4; ++m) {
                float s = 0.f;
#pragma unroll
                for (int bj = 0; bj < 2; ++bj)
#pragma unroll
                    for (int n = 0; n < 2; ++n) { const f32x4 x = v[ai][bj][m][n]; s += (x[0] + x[1]) + (x[2] + x[3]); }
                s += __shfl_xor(s, 16); s += __shfl_xor(s, 32);
                const float mw = s * (1.0f / 64.0f); float q = 0.f;
#pragma unroll
                for (int bj = 0; bj < 2; ++bj)
#pragma unroll
                    for (int n = 0; n < 2; ++n) { const f32x4 d = v[ai][bj][m][n] - mw; q += (d[0] * d[0] + d[1] * d[1]) + (d[2] * d[2] + d[3] * d[3]); }
                q += __shfl_xor(q, 16); q += __shfl_xor(q, 32);
                if (fq == 0) P[(ai * HALF + wr * 64 + m * 16 + fr) * 4 + wc] = (f32x2v){mw, q};
            }
        asm volatile("s_waitcnt lgkmcnt(0)" ::: "memory"); __builtin_amdgcn_s_barrier(); asm volatile("" ::: "memory");
#if defined(BROKEN_EXCHANGE_NO_WAIT)
#warning BROKEN CONTROL BUILD: the row-statistics exchange does not wait; results are wrong by design
        if (blockIdx.x >= 64) { const long long t0_ = clock64(); while (clock64() - t0_ < 60000) __builtin_amdgcn_s_sleep(8); }
#endif
        const int row = wid * 32 + (lane & 31);
        if (lane < 32) {
            const f32x2v a = P[row * 4 + 0], b = P[row * 4 + 1], c = P[row * 4 + 2], d = P[row * 4 + 3];
            const float mt = (a.x + b.x + c.x + d.x) * 0.25f;
            const float da = a.x - mt, db = b.x - mt, dc = c.x - mt, dd = d.x - mt;
            const float m2 = (a.y + b.y) + (c.y + d.y) + 64.0f * ((da * da + db * db) + (dc * dc + dd * dd));
            unsigned long long* slot = (unsigned long long*)xbuf + ((size_t)(u.pm * BM + row) * 4 + u.pn);
            __hip_atomic_store(slot, ((unsigned long long)__float_as_uint(m2) << 32) | __float_as_uint(mt), __ATOMIC_RELAXED, __HIP_MEMORY_SCOPE_AGENT);
        }
        asm volatile("s_waitcnt vmcnt(0)" ::: "memory");
        if (lane == 0) __hip_atomic_fetch_add(cnt + 64 * u.pm, 1u, __ATOMIC_RELAXED, __HIP_MEMORY_SCOPE_AGENT);
        if (wid == 0) {
            bool dead = false; const unsigned long long t0 = __builtin_amdgcn_s_memrealtime(); const unsigned want = 8u * (unsigned)ntn;
            for (;;) {
#if defined(BROKEN_EXCHANGE_NO_WAIT)
                break;
#endif
                if ((unsigned)__builtin_amdgcn_readfirstlane(__hip_atomic_load(cnt + 64 * u.pm, __ATOMIC_RELAXED, __HIP_MEMORY_SCOPE_AGENT)) >= want) break;
                if (__builtin_amdgcn_s_memrealtime() - t0 > 2000000ull) {
                    if (lane == 0) { unsigned expect = 0u; __hip_atomic_compare_exchange_strong(tmo + 1, &expect, code | (unsigned)(u.pm & 0xff), __ATOMIC_RELAXED, __ATOMIC_RELAXED, __HIP_MEMORY_SCOPE_AGENT);
                                     __hip_atomic_store(tmo, 1u, __ATOMIC_RELAXED, __HIP_MEMORY_SCOPE_AGENT); }
                    dead = true; break; }
                __builtin_amdgcn_s_sleep(2);
            }
            __builtin_amdgcn_fence(__ATOMIC_ACQUIRE, "agent");
            if (lane == 0) flag[0] = dead ? 1u : 0u;
        }
        asm volatile("s_waitcnt vmcnt(0) lgkmcnt(0)" ::: "memory"); __builtin_amdgcn_s_barrier(); asm volatile("" ::: "memory");
        const bool bad = flag[0] != 0u;
        if (lane < 32) {
            const unsigned long long* slot = (const unsigned long long*)xbuf + (size_t)(u.pm * BM + row) * 4; float mt[4], m2[4]; float ms = 0.f;
#pragma unroll
            for (int t = 0; t < 4; ++t) { if (t < ntn) { const unsigned long long w = __hip_atomic_load(slot + t, __ATOMIC_RELAXED, __HIP_MEMORY_SCOPE_AGENT); mt[t] = __uint_as_float((unsigned)w); m2[t] = __uint_as_float((unsigned)(w >> 32)); } else { mt[t] = 0.f; m2[t] = 0.f; } ms += mt[t]; }
            const float mean = ms / (float)ntn; float q = 0.f;
#pragma unroll
            for (int t = 0; t < 4; ++t) if (t < ntn) { const float dm = mt[t] - mean; q += m2[t] + 256.0f * dm * dm; }
            S[row] = (f32x2v){mean, 1.0f / sqrtf(q / (256.0f * (float)ntn) + eps)};
        }
        asm volatile("s_waitcnt lgkmcnt(0)" ::: "memory"); __builtin_amdgcn_s_barrier(); asm volatile("" ::: "memory");
        return bad;
    }
};
struct EpiLnRes {
    static constexpr bool PERM = false, AFTER_DRAIN = true;
    const float* base; float* out; int ldc; const float* bias; PanelStats st; unsigned poison;
    __device__ __forceinline__ void fused(f32x4 (&acc)[2][2][4][2], const Unit& u, int wr, int wc, int fr, int fq, PG8_LAS unsigned char* lds, int wid, int lane) const {
        typedef float f32x2v __attribute__((ext_vector_type(2)));
        const PG8_LAS f32x2v* S = (const PG8_LAS f32x2v*)(lds + 8192);
        const int col0 = u.pn * BM + wc * 32 + 4 * fq;
#pragma unroll
        for (int bj = 0; bj < 2; ++bj)
#pragma unroll
            for (int n = 0; n < 2; ++n) { const f32x4 bv = bias ? *(const f32x4*)(bias + col0 + bj * HALF + n * 16) : (f32x4){0.f, 0.f, 0.f, 0.f};
#pragma unroll
                for (int ai = 0; ai < 2; ++ai)
#pragma unroll
                    for (int m = 0; m < 4; ++m) acc[ai][bj][m][n] += bv; }
        f32x4 pre[4][2][2];
#pragma unroll
        for (int m = 0; m < 4; ++m) { const size_t off = (size_t)(u.pm * BM + wr * 64 + m * 16 + fr) * ldc + col0;
#pragma unroll
            for (int bj = 0; bj < 2; ++bj)
#pragma unroll
                for (int n = 0; n < 2; ++n) pre[m][bj][n] = *(const f32x4*)(base + off + bj * HALF + n * 16); }
        const bool bad = st.run(acc, u, wr, wc, fr, fq, lds, wid, lane) || poison != 0u;
        const float qnan = __builtin_nanf("");
#pragma unroll
        for (int ai = 0; ai < 2; ++ai)
#pragma unroll
            for (int m = 0; m < 4; ++m) { const int r = ai * HALF + wr * 64 + m * 16 + fr; const f32x2v sr = S[r]; const size_t off = (size_t)(u.pm * BM + r) * ldc + col0;
#pragma unroll
                for (int bj = 0; bj < 2; ++bj)
#pragma unroll
                    for (int n = 0; n < 2; ++n) { const f32x4 bs = ai == 0 ? pre[m][bj][n] : *(const f32x4*)(base + off + bj * HALF + n * 16); f32x4 o = bs + (acc[ai][bj][m][n] - sr.x) * sr.y;
                        if (bad) o = (f32x4){qnan, qnan, qnan, qnan}; *(f32x4*)(out + off + bj * HALF + n * 16) = o; }
                if (m & 1) asm volatile("" ::: "memory"); }
    }
};
struct EpiLnResLn {
    static constexpr bool PERM = false, AFTER_DRAIN = true;
    const float* base; float* out; bf16_t* xn; int ldc; const float* bias; PanelStats st1, st2; unsigned poison;
    __device__ __forceinline__ void fused(f32x4 (&acc)[2][2][4][2], const Unit& u, int wr, int wc, int fr, int fq, PG8_LAS unsigned char* lds, int wid, int lane) const {
        typedef float f32x2v __attribute__((ext_vector_type(2))); typedef unsigned u32x2v __attribute__((ext_vector_type(2)));
        const PG8_LAS f32x2v* S = (const PG8_LAS f32x2v*)(lds + 8192);
        const int col0 = u.pn * BM + wc * 32 + 4 * fq;
#pragma unroll
        for (int bj = 0; bj < 2; ++bj)
#pragma unroll
            for (int n = 0; n < 2; ++n) { const f32x4 bv = bias ? *(const f32x4*)(bias + col0 + bj * HALF + n * 16) : (f32x4){0.f, 0.f, 0.f, 0.f};
#pragma unroll
                for (int ai = 0; ai < 2; ++ai)
#pragma unroll
                    for (int m = 0; m < 4; ++m) acc[ai][bj][m][n] += bv; }
        bool bad = st1.run(acc, u, wr, wc, fr, fq, lds, wid, lane) || poison != 0u;
        const float qnan = __builtin_nanf("");
#pragma unroll
        for (int ai = 0; ai < 2; ++ai)
#pragma unroll
            for (int m = 0; m < 4; ++m) { const int r = ai * HALF + wr * 64 + m * 16 + fr; const f32x2v sr = S[r]; const size_t off = (size_t)(u.pm * BM + r) * ldc + col0;
#pragma unroll
                for (int bj = 0; bj < 2; ++bj)
#pragma unroll
                    for (int n = 0; n < 2; ++n) { const f32x4 bs = *(const f32x4*)(base + off + bj * HALF + n * 16); acc[ai][bj][m][n] = bs + (acc[ai][bj][m][n] - sr.x) * sr.y; }
                asm volatile("" : "+v"(acc[ai][0][m][0]), "+v"(acc[ai][0][m][1]), "+v"(acc[ai][1][m][0]), "+v"(acc[ai][1][m][1]));
                if (m & 1) asm volatile("" ::: "memory"); }
        const bool bad1 = bad;
        bad = st2.run(acc, u, wr, wc, fr, fq, lds, wid, lane) || bad;
#pragma unroll
        for (int ai = 0; ai < 2; ++ai)
#pragma unroll
            for (int m = 0; m < 4; ++m) { const int r = ai * HALF + wr * 64 + m * 16 + fr; const f32x2v sr = S[r]; const size_t off = (size_t)(u.pm * BM + r) * ldc + col0;
#pragma unroll
                for (int bj = 0; bj < 2; ++bj)
#pragma unroll
                    for (int n = 0; n < 2; ++n) { const f32x4 x1 = acc[ai][bj][m][n]; *(f32x4*)(out + off + bj * HALF + n * 16) = bad1 ? (f32x4){qnan, qnan, qnan, qnan} : x1;
                        const f32x4 o = (x1 - sr.x) * sr.y; u32x2v w; w.x = cvt_pk_bf16(o[0], o[1]); w.y = cvt_pk_bf16(o[2], o[3]);
                        if (bad) { w.x = 0x7fc07fc0u; w.y = 0x7fc07fc0u; } *(u32x2v*)(xn + off + bj * HALF + n * 16) = w; }
                asm volatile("" ::: "memory"); }
    }
};

template <class Epi, class Sched, bool ALIGN_EPI = false, bool SP2 = false>
__device__ __forceinline__ void gemm_phase(PG8_LAS unsigned char* lds, const Gemm g, const Sched& S, const Epi& E) {
    const int tid = threadIdx.x, wid = __builtin_amdgcn_readfirstlane(tid >> 6), lane = tid & 63, wr = wid >> 2, wc = wid & 3, fr = lane & 15, fq = lane >> 4;
    const int K = g.K, nt = K / BK;
    unsigned voffA[2], voffB[2];
#pragma unroll
    for (int i = 0; i < 2; ++i) { int R, C; stage_rc(tid * 16 + i * 8192, R, C); const int Rb = Epi::PERM ? ((R & ~31) + perm32(R & 31)) : R;
        voffA[i] = (unsigned)(R * K + C) * 2u; voffB[i] = (unsigned)(Rb * K + C) * 2u; }
    const size_t kstep = (size_t)(BK * 2);
    const size_t hstep = (size_t)HALF * K * 2;
    const size_t tstep = 2 * hstep;
    const unsigned ldsw = (unsigned)wid * 1024u;
    const int aoff = lds_byte(wr * 64 + fr, fq * 8), boff = lds_byte(wc * 32 + fr, fq * 8);
#define PG8_SA(b, h) (((b) * 2 + (h)) * HTB)
#define PG8_SB(b, h) ((4 + (b) * 2 + (h)) * HTB)
#define PG8_STAGE(bufoff, gbase, voff) do { _Pragma("unroll") for (int _i = 0; _i < 2; ++_i) \
        __builtin_amdgcn_global_load_lds((const unsigned*)((const char*)(gbase) + (voff)[_i]), (PG8_LAS unsigned*)(lds + (bufoff) + ldsw + _i * 8192), 16, 0, 0); } while (0)
#define PG8_LDA(dst, b, h) do { _Pragma("unroll") for (int m = 0; m < 4; ++m) _Pragma("unroll") for (int k = 0; k < 2; ++k) dst[m][k] = *(const PG8_LAS bf16x8*)(lds + PG8_SA(b, h) + aoff + m * 2048 + k * 1024); } while (0)
#define PG8_LDB(dst, b, h) do { _Pragma("unroll") for (int n = 0; n < 2; ++n) _Pragma("unroll") for (int k = 0; k < 2; ++k) dst[n][k] = *(const PG8_LAS bf16x8*)(lds + PG8_SB(b, h) + boff + n * 2048 + k * 1024); } while (0)
#define PG8_MMA(ai, bj, At, Bt) do { __builtin_amdgcn_s_setprio(1); _Pragma("unroll") for (int m = 0; m < 4; ++m) _Pragma("unroll") for (int n = 0; n < 2; ++n) _Pragma("unroll") for (int k = 0; k < 2; ++k) \
        acc[ai][bj][m][n] = __builtin_amdgcn_mfma_f32_16x16x32_bf16(Bt[n][k], At[m][k], acc[ai][bj][m][n], 0, 0, 0); __builtin_amdgcn_s_setprio(0); } while (0)
#define PG8_WAIT_V(n) asm volatile("s_waitcnt vmcnt(" #n ")" ::: "memory")
#define PG8_WAIT_L(n) asm volatile("s_waitcnt lgkmcnt(" #n ")" ::: "memory")
#define PG8_BAR __builtin_amdgcn_s_barrier()
#define PG8_SCHED __builtin_amdgcn_sched_barrier(0)
    Unit cur, nxt; int ui = 0;
    if (!S.next(0, cur)) return;
    f32x4 acc[2][2][4][2];
#pragma unroll
    for (int a = 0; a < 2; ++a)
#pragma unroll
        for (int b = 0; b < 2; ++b)
#pragma unroll
            for (int m = 0; m < 4; ++m)
#pragma unroll
                for (int n = 0; n < 2; ++n) acc[a][b][m][n] = (f32x4){0.f, 0.f, 0.f, 0.f};
    bf16x8 At[4][2], B0[2][2], B1[2][2];
    const char* cA = (const char*)g.A + (size_t)cur.pm * tstep; const char* cB = (const char*)g.Bt + (size_t)cur.pn * tstep;
    S.a_ready(cur);
    if constexpr (SP2) {
        PG8_STAGE(PG8_SB(0, 0), cB, voffB); PG8_STAGE(PG8_SB(0, 1), cB + hstep, voffB); PG8_STAGE(PG8_SA(0, 0), cA, voffA); PG8_STAGE(PG8_SA(0, 1), cA + hstep, voffA);
        if (wr == 1) PG8_BAR;
        PG8_WAIT_V(2); PG8_BAR;
        PG8_STAGE(PG8_SB(1, 0), cB + kstep, voffB); PG8_STAGE(PG8_SA(1, 0), cA + kstep, voffA); PG8_STAGE(PG8_SB(1, 1), cB + hstep + kstep, voffB);
        PG8_WAIT_V(6); PG8_BAR;
    } else {
        PG8_STAGE(PG8_SB(0, 0), cB, voffB); PG8_STAGE(PG8_SA(0, 0), cA, voffA); PG8_STAGE(PG8_SB(0, 1), cB + hstep, voffB); PG8_STAGE(PG8_SA(0, 1), cA + hstep, voffA);
        if (wr == 1) PG8_BAR;
        PG8_WAIT_V(4); PG8_BAR;
        PG8_STAGE(PG8_SB(1, 0), cB + kstep, voffB); PG8_STAGE(PG8_SA(1, 0), cA + kstep, voffA); PG8_STAGE(PG8_SB(1, 1), cB + hstep + kstep, voffB);
        PG8_WAIT_V(6); PG8_BAR;
    }
    for (;;) {
        const bool has_next = S.next(ui + 1, nxt);
        const char* nA = has_next ? (const char*)g.A + (size_t)nxt.pm * tstep : cA; const char* nB = has_next ? (const char*)g.Bt + (size_t)nxt.pn * tstep : cB;
        for (int t = 0; t < nt; t += 2) {
            const bool last = (t == nt - 2);
            const char* a1 = cA + (size_t)(t + 1) * kstep;
            const char* a2 = last ? nA : cA + (size_t)(t + 2) * kstep; const char* b2 = last ? nB : cB + (size_t)(t + 2) * kstep;
            const char* a3 = a2 + kstep; const char* b3 = b2 + kstep;
            if (last && has_next) S.a_ready(nxt);
            if constexpr (SP2) {
            PG8_LDB(B0, 0, 0); PG8_LDB(B1, 0, 1); PG8_SCHED; PG8_LDA(At, 0, 0); PG8_STAGE(PG8_SA(1, 1), a1 + hstep, voffA);
            PG8_WAIT_V(8); PG8_WAIT_L(0); PG8_BAR; PG8_MMA(0, 0, At, B0); PG8_MMA(0, 1, At, B1); PG8_BAR; PG8_SCHED;
            PG8_LDA(At, 0, 1); PG8_STAGE(PG8_SB(0, 0), b2, voffB); PG8_STAGE(PG8_SB(0, 1), b2 + hstep, voffB); PG8_STAGE(PG8_SA(0, 0), a2, voffA);
            PG8_WAIT_V(8); PG8_WAIT_L(0); PG8_BAR; PG8_MMA(1, 0, At, B0); PG8_MMA(1, 1, At, B1); PG8_BAR; PG8_SCHED;
            PG8_LDB(B0, 1, 0); PG8_LDB(B1, 1, 1); PG8_SCHED; PG8_LDA(At, 1, 0); PG8_STAGE(PG8_SA(0, 1), a2 + hstep, voffA);
            PG8_WAIT_V(8); PG8_WAIT_L(0); PG8_BAR; PG8_MMA(0, 0, At, B0); PG8_MMA(0, 1, At, B1); PG8_BAR; PG8_SCHED;
            PG8_LDA(At, 1, 1); PG8_STAGE(PG8_SB(1, 0), b3, voffB); PG8_STAGE(PG8_SB(1, 1), b3 + hstep, voffB); PG8_STAGE(PG8_SA(1, 0), a3, voffA);
            PG8_WAIT_V(8); PG8_WAIT_L(0); PG8_BAR; PG8_MMA(1, 0, At, B0); PG8_MMA(1, 1, At, B1); PG8_BAR; PG8_SCHED;
            } else {
            PG8_LDB(B0, 0, 0); PG8_SCHED; PG8_LDA(At, 0, 0); PG8_STAGE(PG8_SA(1, 1), a1 + hstep, voffA);
            PG8_WAIT_L(8); PG8_BAR; PG8_WAIT_L(0); PG8_MMA(0, 0, At, B0); PG8_BAR; PG8_SCHED;
            PG8_LDB(B1, 0, 1); PG8_STAGE(PG8_SB(0, 0), b2, voffB);
            PG8_BAR; PG8_WAIT_L(0); PG8_MMA(0, 1, At, B1); PG8_BAR;
            PG8_LDA(At, 0, 1); PG8_STAGE(PG8_SA(0, 0), a2, voffA);
            PG8_BAR; PG8_WAIT_L(0); PG8_MMA(1, 0, At, B0); PG8_BAR; PG8_SCHED;
            PG8_STAGE(PG8_SB(0, 1), b2 + hstep, voffB);
            PG8_WAIT_V(6); PG8_BAR; PG8_MMA(1, 1, At, B1); PG8_BAR;
            PG8_LDB(B0, 1, 0); PG8_SCHED; PG8_LDA(At, 1, 0); PG8_STAGE(PG8_SA(0, 1), a2 + hstep, voffA);
            PG8_WAIT_L(8); PG8_BAR; PG8_WAIT_L(0); PG8_MMA(0, 0, At, B0); PG8_BAR; PG8_SCHED;
            PG8_LDB(B1, 1, 1); PG8_STAGE(PG8_SB(1, 0), b3, voffB);
            PG8_BAR; PG8_WAIT_L(0); PG8_MMA(0, 1, At, B1); PG8_BAR;
            PG8_LDA(At, 1, 1); PG8_STAGE(PG8_SA(1, 0), a3, voffA);
            PG8_BAR; PG8_WAIT_L(0); PG8_MMA(1, 0, At, B0); PG8_BAR; PG8_SCHED;
            PG8_STAGE(PG8_SB(1, 1), b3 + hstep, voffB);
            PG8_WAIT_V(6); PG8_BAR; PG8_MMA(1, 1, At, B1); PG8_BAR;
            }
        }
        if constexpr (ALIGN_EPI) { if (wr == 0) PG8_BAR; }
        if constexpr (!Epi::AFTER_DRAIN) { E(acc, cur, wr, wc, fr, fq); S.done(cur); }
        if (!has_next) break;
#pragma unroll
        for (int a = 0; a < 2; ++a)
#pragma unroll
            for (int b = 0; b < 2; ++b)
#pragma unroll
                for (int m = 0; m < 4; ++m)
#pragma unroll
                    for (int n = 0; n < 2; ++n) acc[a][b][m][n] = (f32x4){0.f, 0.f, 0.f, 0.f};
        cur = nxt; cA = nA; cB = nB; ++ui;
        if constexpr (ALIGN_EPI) { if (wr == 1) PG8_BAR; }
    }
    PG8_WAIT_V(0);
    if constexpr (!ALIGN_EPI) { if (wr == 0) PG8_BAR; }
    PG8_BAR;
    if constexpr (Epi::AFTER_DRAIN) { E.fused(acc, cur, wr, wc, fr, fq, lds, wid, lane); S.done(cur); }
#undef PG8_SA
#undef PG8_SB
#undef PG8_STAGE
#undef PG8_LDA
#undef PG8_LDB
#undef PG8_MMA
#undef PG8_WAIT_V
#undef PG8_WAIT_L
#undef PG8_BAR
#undef PG8_SCHED
}
}
#ifndef PG8_SP2
#define PG8_SP2 true
#endif
#ifndef PG8_ALIGN
#define PG8_ALIGN true
#endif
constexpr int NWAVES = 8;
constexpr int MP = 32768, MS = 1024, MT = MP + MS;
constexpr int SEQ = 8192, NB = 4, DB = 128, DSEQ = 8, WIN = 2048;
constexpr int DM = 1024, DIN = 4096;
constexpr float LN_EPS = 1e-5f;
constexpr float ALPHA_F = 1.189207115002721f;
constexpr float LOG2E = 1.4426950408889634f;
constexpr size_t MiB = 1u << 20;
constexpr size_t WS_CTL = 0, CTL_ZERO_BYTES = 1 * MiB;
constexpr size_t WS_WTIN = 2 * MiB, WS_WTOUT = 10 * MiB, WS_LBV = 12 * MiB, WS_BIAST = 12 * MiB + 4096, WS_BS = 12 * MiB + 32768;
constexpr size_t WS_XB = 560 * MiB;
constexpr size_t SEG_STRIDE = 36 * MiB;
constexpr size_t WS_QA = 60 * MiB, WS_KA = WS_QA + SEG_STRIDE, WS_VA = WS_QA + 2 * SEG_STRIDE, WS_GA = WS_QA + 3 * SEG_STRIDE, WS_QB = WS_QA + 4 * SEG_STRIDE, WS_VB = WS_QA + 6 * SEG_STRIDE, WS_GB = WS_QA + 7 * SEG_STRIDE;
constexpr size_t WS_GF = 348 * MiB, WS_MIX = 420 * MiB, WS_OP = 1404 * MiB  , WS_LSE = 552 * MiB;
constexpr size_t WS_HL = 636 * MiB, WS_HD = 654 * MiB, WS_HS = 656 * MiB;
constexpr size_t WS_H32 = 700 * MiB, WS_ATTN32 = 1260 * MiB, WS_OG32 = 1332 * MiB, WS_SPART = 1500 * MiB, WS_END = 1540 * MiB;
constexpr int CW_TMO = 0, CW_CODE = 1, CW_BAR = 4096;
constexpr int RING_OFF = 0, RING_BYTES = 131072;
constexpr int LDSCTL_OFF = RING_BYTES, MISC_OFF = LDSCTL_OFF + 320;
constexpr int LDS_BYTES = 147456;

#define GAS __attribute__((address_space(1)))
#define LAS __attribute__((address_space(3)))
typedef unsigned short bf16;
typedef unsigned v4u __attribute__((ext_vector_type(4)));
typedef unsigned v2u __attribute__((ext_vector_type(2)));
typedef float f32x4 __attribute__((ext_vector_type(4)));
typedef short bf16x8 __attribute__((ext_vector_type(8)));
typedef GAS unsigned gu32;
#define RLX_AGENT __ATOMIC_RELAXED, __HIP_MEMORY_SCOPE_AGENT
#define LDS_WAIT() asm volatile("s_waitcnt lgkmcnt(0)" ::: "memory")
#define VM_WAIT() asm volatile("s_waitcnt vmcnt(0)" ::: "memory")
__device__ __forceinline__ unsigned f2bf(float f) { unsigned u = __builtin_bit_cast(unsigned, f); return (u + 0x7fffu + ((u >> 16) & 1u)) >> 16; }
__device__ __forceinline__ unsigned pk2(float lo, float hi) { return f2bf(lo) | (f2bf(hi) << 16); }
__device__ __forceinline__ float bf2f(unsigned short b) { return __builtin_bit_cast(float, (unsigned)b << 16); }
__device__ __forceinline__ float fast_sigmoid(float x) { return __builtin_amdgcn_rcpf(1.0f + __expf(-x)); }
__device__ __forceinline__ float fast_silu(float x) { return x * fast_sigmoid(x); }

namespace pg8 {
struct EpiInProj {
    static constexpr bool PERM = true, AFTER_DRAIN = false;
    unsigned char* ws; float* out; int dbg;
    __device__ __forceinline__ void operator()(const f32x4 (&acc)[2][2][4][2], const Unit& u, int wr, int wc, int fr, int fq) const {
        const int seg = u.pn >> 1;
        const int cs0 = (u.pn & 1) * 256 + wc * 32 + 8 * fq;
        const int row0 = u.pm * BM + wr * 64 + fr;
        const bool is_sample = u.pm >= 128;
        const bool win = (seg == 1 || seg == 2) && (is_sample || ((u.pm & 31) >= 24));
        float* wbase = out + (size_t)MT * DM + (is_sample ? (size_t)2 * NB * WIN * 512 + (seg == 2 ? (size_t)DB * WIN * 512 : 0) : (seg == 2 ? (size_t)NB * WIN * 512 : 0));
        bf16_t* ob = (bf16_t*)(ws + WS_QA + (size_t)seg * SEG_STRIDE);
        float* GF = (float*)(ws + WS_GF); const float* lbv = (const float*)(ws + WS_LBV); float* H32 = (float*)(ws + WS_H32);
#pragma unroll
        for (int ai = 0; ai < 2; ++ai)
#pragma unroll
            for (int m = 0; m < 4; ++m) {
                const int row = row0 + ai * HALF + m * 16;
                size_t wrow = 0;
                if (win) { if (is_sample) { const int rs = row - 32768; wrow = (size_t)(rs >> 3) * 2048 + 2040 + (rs & 7); } else { wrow = (size_t)(row >> 13) * 2048 + ((row & 8191) - 6144); } }
#pragma unroll
                for (int bj = 0; bj < 2; ++bj) {
                    const int cs = cs0 + bj * HALF;
                    f32x4 v0 = acc[ai][bj][m][0], v1 = acc[ai][bj][m][1];
                    if (dbg) { float* hp = H32 + (size_t)row * 4096 + seg * 512 + cs; *(f32x4*)hp = v0; *(f32x4*)(hp + 4) = v1; }
                    if (win) { float* wp = wbase + wrow * 512 + cs; *(f32x4*)wp = v0; *(f32x4*)(wp + 4) = v1; }
                    if (seg == 5) {
                        const f32x4 l0 = *(const f32x4*)(lbv + cs), l1 = *(const f32x4*)(lbv + cs + 4);
                        f32x4 g0, g1;
#pragma unroll
                        for (int i = 0; i < 4; ++i) { g0[i] = __logf(l0[i] + (1.0f - l0[i]) * fast_sigmoid(v0[i])); g1[i] = __logf(l1[i] + (1.0f - l1[i]) * fast_sigmoid(v1[i])); }
                        float* gp = GF + (size_t)row * 512 + cs; *(f32x4*)gp = g0; *(f32x4*)(gp + 4) = g1;
                    } else {
                        if (seg == 0) { v0 = v0 * 0.125f; v1 = v1 * 0.125f; }
                        else if (seg == 3 || seg == 7) {
#pragma unroll
                            for (int i = 0; i < 4; ++i) { v0[i] = fast_silu(v0[i]); v1[i] = fast_silu(v1[i]); }
                        } else if (seg == 4) {
#pragma unroll
                            for (int i = 0; i < 4; ++i) { v0[i] = fast_silu(v0[i]) * 0.08838834764831845f; v1[i] = fast_silu(v1[i]) * 0.08838834764831845f; }
                        }
                        u32x4 w; w.x = cvt_pk_bf16(v0[0], v0[1]); w.y = cvt_pk_bf16(v0[2], v0[3]); w.z = cvt_pk_bf16(v1[0], v1[1]); w.w = cvt_pk_bf16(v1[2], v1[3]);
                        *(u32x4*)(ob + (size_t)row * 512 + cs) = w;
                    }
                }
            }
    }
};
struct EpiZ {
    static constexpr bool PERM = true, AFTER_DRAIN = false;
    const float* xp; const float* xs; float* out;
    __device__ __forceinline__ void operator()(const f32x4 (&acc)[2][2][4][2], const Unit& u, int wr, int wc, int fr, int fq) const {
        const int row0 = u.pm * BM + wr * 64 + fr, col0 = u.pn * BM + wc * 32 + 8 * fq;
        const float* xb = (u.pm >= 128) ? (xs - (size_t)32768 * 1024) : xp;
#pragma unroll
        for (int ai = 0; ai < 2; ++ai)
#pragma unroll
            for (int m = 0; m < 4; ++m) {
                const size_t off = (size_t)(row0 + ai * HALF + m * 16) * 1024 + col0;
#pragma unroll
                for (int bj = 0; bj < 2; ++bj) {
                    const f32x4 x0 = *(const f32x4*)(xb + off + bj * HALF), x1 = *(const f32x4*)(xb + off + bj * HALF + 4);
                    *(f32x4*)(out + off + bj * HALF) = acc[ai][bj][m][0] + x0 * 1.189207115002721f;
                    *(f32x4*)(out + off + bj * HALF + 4) = acc[ai][bj][m][1] + x1 * 1.189207115002721f;
                }
            }
    }
};
}

#define XB_TMO      128
#define XB_XCNT(j)  (256  + 64 * (j))
#define XB_XSUB(j)  (1280 + 64 * (j))
#define XB_XGEN(j)  (2304 + 64 * (j))
#define XB_TOP      3328
#define XB_TOPGEN   3392
#define XCD_BAR_WORDS 3456
#define XB_SPIN_CAP (1u << 18)
__device__ __forceinline__ unsigned xb_ld(unsigned* p)              { return __hip_atomic_load(p, __ATOMIC_RELAXED, __HIP_MEMORY_SCOPE_AGENT); }
__device__ __forceinline__ unsigned xb_add(unsigned* p, unsigned v) { return __hip_atomic_fetch_add(p, v, __ATOMIC_RELAXED, __HIP_MEMORY_SCOPE_AGENT); }
__device__ __forceinline__ unsigned xb_xcc_id() { return (unsigned)__builtin_amdgcn_s_getreg((3 << 11) | 20) & 0xFu; }
#define XB_SPIN(cond, bar) do { unsigned _sp = 0; while (cond) { __builtin_amdgcn_s_sleep(1); \
    if ((++_sp & 255u) == 0u) { if (xb_ld(&(bar)[XB_TMO])) break; if (_sp > XB_SPIN_CAP) { atomicAdd(&(bar)[XB_TMO], 1u); break; } } } } while (0)
struct XcdBarrier { unsigned* bar; unsigned x; volatile LAS unsigned* st; };
__device__ __forceinline__ XcdBarrier xcd_barrier_post(unsigned* bar, volatile LAS unsigned* st) {
    XcdBarrier b; b.bar = bar; b.x = xb_xcc_id(); b.st = st;
    if (threadIdx.x == 0) (void)xb_add(&bar[XB_XCNT(b.x)], 1u);
    return b;
}
__device__ __forceinline__ void xcd_barrier_complete(unsigned* bar, unsigned x, unsigned& nloc, unsigned& nx) {
    const unsigned G = gridDim.x * gridDim.y * gridDim.z;
    unsigned sum, cnt, mine, sp = 0u;
    for (;;) {
        sum = 0u; cnt = 0u; mine = 0u;
#pragma unroll
        for (unsigned j = 0; j < 16; ++j) { const unsigned c = xb_ld(&bar[XB_XCNT(j)]); sum += c; cnt += (c > 0u) ? 1u : 0u; mine = (j == x) ? c : mine; }
        if (sum == G) break;
        __builtin_amdgcn_s_sleep(1);
        if ((++sp & 255u) == 0u) { if (xb_ld(&bar[XB_TMO])) break; if (sp > XB_SPIN_CAP) { atomicAdd(&bar[XB_TMO], 1u); break; } }
    }
    nloc = mine > 0u ? mine : 1u; nx = cnt > 0u ? cnt : 1u;
}
__device__ __forceinline__ void xcd_barrier(const XcdBarrier& b) {
    asm volatile("s_waitcnt vmcnt(0)" ::: "memory");
    __syncthreads();
    if (threadIdx.x == 0) {
        unsigned* bar = b.bar;
        __builtin_amdgcn_s_waitcnt(0);
        unsigned nloc = b.st[0], nx = b.st[1];
        if (nloc == 0u) { xcd_barrier_complete(bar, b.x, nloc, nx); b.st[0] = nloc; b.st[1] = nx; }
        const unsigned old = xb_add(&bar[XB_XSUB(b.x)], 1u);
        const unsigned gen = old / nloc;
        if (old + 1u == (gen + 1u) * nloc) {
            __builtin_amdgcn_fence(__ATOMIC_RELEASE, "agent");
            asm volatile("s_waitcnt vmcnt(0)" ::: "memory");
            const unsigned og = xb_add(&bar[XB_TOP], 1u);
            const unsigned tg = og / nx;
            if (og + 1u == (tg + 1u) * nx) xb_add(&bar[XB_TOPGEN], 1u);
            else XB_SPIN(xb_ld(&bar[XB_TOPGEN]) == tg, bar);
            __builtin_amdgcn_fence(__ATOMIC_ACQUIRE, "agent");
            xb_add(&bar[XB_XGEN(b.x)], 1u);
            asm volatile("s_waitcnt vmcnt(0)" ::: "memory");
        } else {
            XB_SPIN(xb_ld(&bar[XB_XGEN(b.x)]) == gen, bar);
            __builtin_amdgcn_fence(__ATOMIC_ACQUIRE, "agent");
            asm volatile("s_waitcnt vmcnt(0)" ::: "memory");
        }
    }
    __syncthreads();
}

struct Frame {
    LAS unsigned char* lds;
    volatile LAS unsigned* MISC;
    gu32* ctl;
    int tid, lane, wave, vcu, G;
};
struct Args {
    const float* in[12]; float* out; unsigned char* ws; int ph_lo, ph_hi; int dbg_h32; int pad;
};

__device__ __forceinline__ float wave_sum(float v) {
#pragma unroll
    for (int o = 1; o < 64; o <<= 1) v += __shfl_xor(v, o);
    return v;
}
__device__ __forceinline__ void p0_transpose_item(const float* W, int K, int N, bf16* WT, LAS float* scr, int item, int lane) {
    const int nblk = N / 32, kb = item / nblk, nb = item % nblk, k0 = 64 * kb, n0 = 32 * nb;
#pragma unroll 8
    for (int i = 0; i < 32; ++i) { const int kk = 2 * i + (lane >> 5); scr[kk * 33 + (lane & 31)] = W[(size_t)(k0 + kk) * N + n0 + (lane & 31)]; }
    LDS_WAIT(); asm volatile("" ::: "memory");
    const int c = lane & 7;
#pragma unroll
    for (int j = 0; j < 4; ++j) { const int n = (lane >> 3) + 8 * j; const LAS float* s = scr + (8 * c) * 33 + n;
        v4u o; o.x = pk2(s[0 * 33], s[1 * 33]); o.y = pk2(s[2 * 33], s[3 * 33]); o.z = pk2(s[4 * 33], s[5 * 33]); o.w = pk2(s[6 * 33], s[7 * 33]);
        *(GAS v4u*)(WT + (size_t)(n0 + n) * K + k0 + 8 * c) = o; }
    LDS_WAIT(); asm volatile("" ::: "memory");
}
__device__ __forceinline__ int rel_bucket_dev(int d) {
    if (d < 16) return d;
    int b = 16;
    b += (d >= 22); b += (d >= 30); b += (d >= 40); b += (d >= 54); b += (d >= 73); b += (d >= 99); b += (d >= 134); b += (d >= 182);
    b += (d >= 246); b += (d >= 332); b += (d >= 450); b += (d >= 609); b += (d >= 825); b += (d >= 1117); b += (d >= 1513);
    return b;
}
__device__ __forceinline__ void p0_prologue(Frame& F, const Args& A) {
    LAS float* scr = (LAS float*)(F.lds + RING_OFF + F.wave * 16384);
    const int gw = F.vcu * NWAVES + F.wave, NGW = F.G * NWAVES;
    bf16* WTin = (bf16*)(A.ws + WS_WTIN); bf16* WTout = (bf16*)(A.ws + WS_WTOUT); bf16* XB = (bf16*)(A.ws + WS_XB);
    constexpr int I_IN = (DM / 64) * (DIN / 32), I_OUT = (DM / 64) * (DM / 32);
    for (int it = gw; it < I_IN + I_OUT; it += NGW) {
        if (it < I_IN) p0_transpose_item(A.in[5], DM, DIN, WTin, scr, it, F.lane);
        else p0_transpose_item(A.in[6], DM, DM, WTout, scr, it - I_IN, F.lane);
    }
    for (int m = gw; m < MT; m += NGW) {
        const float* xrow = (m < MP) ? A.in[0] + (size_t)m * DM : A.in[1] + (size_t)(m - MP) * DM;
        const GAS f32x4* xr = (const GAS f32x4*)xrow + F.lane;
        GAS v2u* o8 = (GAS v2u*)(XB + (size_t)m * DM) + F.lane;
#pragma unroll
        for (int j = 0; j < 4; ++j) { const f32x4 v = xr[64 * j]; v2u w; w.x = pk2(v.x, v.y); w.y = pk2(v.z, v.w); o8[64 * j] = w; }
    }
    { float* bs = (float*)(A.ws + WS_BS);
      for (int i = blockIdx.x * (NWAVES * 64) + F.tid; i < 2049 * 8; i += F.G * NWAVES * 64) bs[i] = A.in[7][rel_bucket_dev(i >> 3) * 8 + (i & 7)] * LOG2E; }
    if (blockIdx.x == 0) {
        float* lbv = (float*)(A.ws + WS_LBV); float* bt = (float*)(A.ws + WS_BIAST);
        const int t = F.tid;
        { const float a0 = A.in[8][t], a1 = A.in[8][512 + t]; lbv[t] = 1.0f / (1.0f + expf(a1 - a0)); }
        for (int i = t; i < 3 * 8 * 132; i += NWAVES * 64) {
            const int j = i % 132, hh = (i / 132) % 8, c = i / (132 * 8);
            const int dil = c == 0 ? 1 : (c == 1 ? 4 : 16);
            bt[i] = (j <= 128) ? A.in[7][rel_bucket_dev(dil * j) * 8 + hh] * LOG2E : 0.f;
        }
    }
}
__device__ __forceinline__ void ln_row_inplace(float* zrow, const float* g, const float* b, int lane) {
    GAS f32x4* zr = (GAS f32x4*)zrow + lane;
    f32x4 v[4]; float s = 0.f;
#pragma unroll
    for (int j = 0; j < 4; ++j) { v[j] = zr[64 * j]; s += (v[j].x + v[j].y) + (v[j].z + v[j].w); }
    const float mean = wave_sum(s) * (1.f / DM); float s2 = 0.f;
#pragma unroll
    for (int j = 0; j < 4; ++j) { v[j] = v[j] - mean; s2 += (v[j].x * v[j].x + v[j].y * v[j].y) + (v[j].z * v[j].z + v[j].w * v[j].w); }
    const float rstd = 1.f / sqrtf(wave_sum(s2) * (1.f / DM) + LN_EPS);
#pragma unroll
    for (int j = 0; j < 4; ++j) { const f32x4 gg = *((const f32x4*)g + lane + 64 * j), bb = *((const f32x4*)b + lane + 64 * j); zr[64 * j] = v[j] * rstd * gg + bb; }
}
namespace attn {
typedef float f32x16 __attribute__((ext_vector_type(16)));
typedef short s16x4 __attribute__((ext_vector_type(4)));
constexpr int KROWS = 384;
constexpr int L_K = 0, L_V = KROWS * 128, L_BIAS = 2 * KROWS * 128, L_END = L_BIAS + 544;
__device__ __forceinline__ int swz(int r) { return (((r >> 1) & 1) << 2) | ((r >> 2) & 3); }
__device__ __forceinline__ int crow(int reg, int hi) { return (reg & 3) + 8 * (reg >> 2) + 4 * hi; }
__device__ __forceinline__ s16x4 tr_read(LAS const unsigned char* p) {
    typedef short v4s __attribute__((ext_vector_type(4)));
    return __builtin_bit_cast(s16x4, __builtin_amdgcn_ds_read_tr16_b64_v4i16((LAS v4s*)p));
}
struct Tensors { const bf16* Q; const bf16* K; const bf16* V; bf16* OP; float* LSE; const float* biasT; };

__device__ __forceinline__ void unit(LAS unsigned char* lds, const Tensors& T, int cfg, int b, int h, int res, int qb, int tid) {
    const int lane = tid & 63, wid = __builtin_amdgcn_readfirstlane(tid >> 6), r32 = lane & 31, hi = lane >> 5;
    const int dil = cfg == 0 ? 1 : (cfg == 1 ? 4 : 16);
    const int P0 = qb * 256;
    const size_t rowb = (size_t)b * SEQ;
    {
        const bf16* Kh = T.K + h * 64; const bf16* Vh = T.V + h * 64;
#pragma unroll
        for (int i = 0; i < 6; ++i) {
            const int e = tid + i * 512;
            const int row = e >> 3, ch = e & 7;
            int pos = P0 - 128 + row; pos = pos < 0 ? 0 : pos;
            const size_t g = (rowb + (size_t)pos * dil + res) * 512 + ch * 8;
            const v4u kv = *(const v4u*)(Kh + g), vv = *(const v4u*)(Vh + g);
            const int off = row * 128 + ((ch ^ swz(row)) << 4);
            *(LAS v4u*)(lds + L_K + off) = kv; *(LAS v4u*)(lds + L_V + off) = vv;
        }
        if (tid < 132) ((LAS float*)(lds + L_BIAS))[tid] = T.biasT[(cfg * 8 + h) * 132 + tid];
    }
    const int qpos = P0 + 32 * wid + r32;
    const size_t qtok = rowb + (size_t)qpos * dil + res;
    bf16x8 qf[4];
#pragma unroll
    for (int d0 = 0; d0 < 4; ++d0) qf[d0] = *(const bf16x8*)(T.Q + qtok * 512 + h * 64 + d0 * 16 + hi * 8);
    __syncthreads();
    float m = -1e30f, l = 0.f;
    f32x16 o0 = {}, o1 = {};
    const LAS float* bias = (const LAS float*)(lds + L_BIAS);
#pragma unroll 1
    for (int kt = 0; kt < 5; ++kt) {
        const int krow0 = 32 * (wid + kt);
        f32x16 s = {};
        {
            const int row = krow0 + r32; const int sw = swz(row);
            const LAS unsigned char* kb = lds + L_K + row * 128;
#pragma unroll
            for (int d0 = 0; d0 < 4; ++d0) {
                const bf16x8 kf = *(const LAS bf16x8*)(kb + (((2 * d0 + hi) ^ sw) << 4));
                s = __builtin_amdgcn_mfma_f32_32x32x16_bf16(kf, qf[d0], s, 0, 0, 0);
            }
        }
        float mx = -1e30f;
#pragma unroll
        for (int r = 0; r < 16; ++r) {
            const int kr = crow(r, hi);
            const int delta = 128 + r32 - 32 * kt - kr;
            const bool ok = (delta >= 0) && (delta <= 128) && (P0 - 128 + krow0 + kr >= 0);
            const int dc = delta < 0 ? 0 : (delta > 128 ? 128 : delta);
            const float v = s[r] * LOG2E + bias[dc];
            s[r] = ok ? v : -1e30f;
            mx = fmaxf(mx, s[r]);
        }
        mx = fmaxf(mx, __shfl_xor(mx, 32));
        const float mn = fmaxf(m, mx);
        const float corr = __builtin_amdgcn_exp2f(m - mn);
        m = mn;
        float ps = 0.f;
#pragma unroll
        for (int r = 0; r < 16; ++r) { s[r] = __builtin_amdgcn_exp2f(s[r] - mn); ps += s[r]; }
        l = l * corr + ps;
#pragma unroll
        for (int r = 0; r < 16; ++r) { o0[r] *= corr; o1[r] *= corr; }
        bf16x8 pf[2];
#pragma unroll
        for (int ks = 0; ks < 2; ++ks) {
            v4u w; w.x = pk2(s[8 * ks + 0], s[8 * ks + 1]); w.y = pk2(s[8 * ks + 2], s[8 * ks + 3]); w.z = pk2(s[8 * ks + 4], s[8 * ks + 5]); w.w = pk2(s[8 * ks + 6], s[8 * ks + 7]);
            pf[ks] = __builtin_bit_cast(bf16x8, w);
        }
#pragma unroll
        for (int ks = 0; ks < 2; ++ks) {
#pragma unroll
            for (int db = 0; db < 2; ++db) {
                s16x4 lo, hh;
                {
                    const int c = 4 * db + 2 * ((lane >> 4) & 1) + ((lane & 3) >> 1);
                    const int krA = krow0 + 16 * ks + 4 * hi + ((lane & 15) >> 2);
                    const int krB = krA + 8;
                    lo = tr_read(lds + L_V + krA * 128 + ((c ^ swz(krA)) << 4) + 8 * (lane & 1));
                    hh = tr_read(lds + L_V + krB * 128 + ((c ^ swz(krB)) << 4) + 8 * (lane & 1));
                }
                const bf16x8 vf = (bf16x8){lo[0], lo[1], lo[2], lo[3], hh[0], hh[1], hh[2], hh[3]};
                if (db == 0) o0 = __builtin_amdgcn_mfma_f32_32x32x16_bf16(vf, pf[ks], o0, 0, 0, 0);
                else o1 = __builtin_amdgcn_mfma_f32_32x32x16_bf16(vf, pf[ks], o1, 0, 0, 0);
            }
        }
    }
    const float lt = l + __shfl_xor(l, 32);
    const float inv = 1.0f / lt;
    bf16* op = T.OP + ((size_t)cfg * MP + qtok) * 512 + h * 64;
#pragma unroll
    for (int g = 0; g < 4; ++g) {
        v2u w0, w1;
        w0.x = pk2(o0[4 * g] * inv, o0[4 * g + 1] * inv); w0.y = pk2(o0[4 * g + 2] * inv, o0[4 * g + 3] * inv);
        w1.x = pk2(o1[4 * g] * inv, o1[4 * g + 1] * inv); w1.y = pk2(o1[4 * g + 2] * inv, o1[4 * g + 3] * inv);
        *(v2u*)(op + 8 * g + 4 * hi) = w0;
        *(v2u*)(op + 32 + 8 * g + 4 * hi) = w1;
    }
    if (hi == 0) T.LSE[((size_t)cfg * MP + qtok) * 8 + h] = m + __builtin_amdgcn_logf(lt);
    __syncthreads();
}
__device__ __forceinline__ void phase(LAS unsigned char* lds, const Tensors& T, int vcu, int G, int tid) {
    constexpr int NUNITS = 3 * NB * 8 * 32;
    for (int u = vcu; u < NUNITS; u += G) {
        const int j = u & 31, h = (u >> 5) & 7, b = (u >> 8) & 3, cfg = u >> 10;
        const int dil = cfg == 0 ? 1 : (cfg == 1 ? 4 : 16);
        const int nblk = 32 / dil;
        const int res = j / nblk, qb = j % nblk;
        unit(lds, T, cfg, b, h, res, qb, tid);
    }
}
__device__ __forceinline__ void combine(const Tensors& T, const bf16* GA, bf16* MIX, int gtid, int gthreads) {
    for (int i = gtid; i < MP * 64; i += gthreads) {
        const int tok = i >> 6, ch = i & 63, h = ch >> 3;
        const float l0 = T.LSE[((size_t)0 * MP + tok) * 8 + h], l1 = T.LSE[((size_t)1 * MP + tok) * 8 + h], l2 = T.LSE[((size_t)2 * MP + tok) * 8 + h];
        const float mx = fmaxf(l0, fmaxf(l1, l2));
        float w0 = __builtin_amdgcn_exp2f(l0 - mx), w1 = __builtin_amdgcn_exp2f(l1 - mx), w2 = __builtin_amdgcn_exp2f(l2 - mx);
        const float inv = 1.0f / (w0 + w1 + w2); w0 *= inv; w1 *= inv; w2 *= inv;
        const v4u a0 = *(const v4u*)(T.OP + ((size_t)0 * MP + tok) * 512 + ch * 8), a1 = *(const v4u*)(T.OP + ((size_t)1 * MP + tok) * 512 + ch * 8), a2 = *(const v4u*)(T.OP + ((size_t)2 * MP + tok) * 512 + ch * 8);
        const v4u gg = *(const v4u*)(GA + (size_t)tok * 512 + ch * 8);
        v4u o;
#pragma unroll
        for (int k = 0; k < 4; ++k) {
            const float lo = (w0 * bf2f((unsigned short)(a0[k] & 0xffff)) + w1 * bf2f((unsigned short)(a1[k] & 0xffff)) + w2 * bf2f((unsigned short)(a2[k] & 0xffff))) * bf2f((unsigned short)(gg[k] & 0xffff));
            const float hi_ = (w0 * bf2f((unsigned short)(a0[k] >> 16)) + w1 * bf2f((unsigned short)(a1[k] >> 16)) + w2 * bf2f((unsigned short)(a2[k] >> 16))) * bf2f((unsigned short)(gg[k] >> 16));
            o[k] = pk2(lo, hi_);
        }
        *(v4u*)(MIX + (size_t)tok * 1024 + ch * 8) = o;
    }
}
}
namespace hg {
typedef float f32x16 __attribute__((ext_vector_type(16)));
typedef short s16x4 __attribute__((ext_vector_type(4)));
typedef float f32x2 __attribute__((ext_vector_type(2)));
constexpr int SC = 512, NSC = SEQ / SC, NSUB = SC / 64;
constexpr int L_QT = 0, L_QH = 16384, L_KT = 32768, L_KH = 49152, L_V = 65536, L_TOT = 81920, L_EBC = 86016, L_OUT = 86528, L_END = L_OUT + 64 * 132 * 4;
static_assert(L_END <= RING_BYTES, "hgrn LDS");
__device__ __forceinline__ int a_row(int row, int c) { return row * 256 + ((c ^ (row & 15)) << 4); }
__device__ __forceinline__ int a_qt(int row, int gq) { return row * 256 + ((gq ^ (row & 31)) << 3); }
__device__ __forceinline__ int a_tr(int row, int c) { return row * 256 + ((c ^ ((row & 3) << 2)) << 4); }
__device__ __forceinline__ int crow(int reg, int hi) { return (reg & 3) + 8 * (reg >> 2) + 4 * hi; }
__device__ __forceinline__ s16x4 tr_read(LAS const unsigned char* p) {
    typedef short v4s __attribute__((ext_vector_type(4)));
    return __builtin_bit_cast(s16x4, __builtin_amdgcn_ds_read_tr16_b64_v4i16((LAS v4s*)p));
}
__device__ __forceinline__ bf16x8 pack8(const f32x16& x, int base) {
    v4u w; w.x = pk2(x[base + 0], x[base + 1]); w.y = pk2(x[base + 2], x[base + 3]); w.z = pk2(x[base + 4], x[base + 5]); w.w = pk2(x[base + 6], x[base + 7]);
    return __builtin_bit_cast(bf16x8, w);
}
struct Tensors { const float* GF; const bf16* QB; const bf16* VB; const bf16* GB; const float* norm_g; bf16* MIX; float* PL; float* PD; float* PS; };

template <int MODE>
__device__ __forceinline__ void unit(LAS unsigned char* lds, const Tensors& T, int b, int hh, int sc, int tid) {
    const int lane = tid & 63, wid = __builtin_amdgcn_readfirstlane(tid >> 6), r32 = lane & 31, hi = lane >> 5;
    const int vt = wid & 3, th = wid >> 2;
    const int uidx = (b * 4 + hh) * NSC + sc;
    const size_t row_base = (size_t)b * SEQ + (size_t)sc * SC;
    f32x16 S[4];
#pragma unroll
    for (int kt = 0; kt < 4; ++kt) {
        if (MODE == 1 && sc > 0) {
            const float* hs = T.PS + (size_t)uidx * 16384;
#pragma unroll
            for (int r = 0; r < 16; ++r) S[kt][r] = hs[(32 * kt + crow(r, hi)) * 128 + 32 * vt + r32];
        } else {
#pragma unroll
            for (int r = 0; r < 16; ++r) S[kt][r] = 0.f;
        }
    }
    const int kp = tid & 63, seg = wid;
    float dlog0 = 0.f, dlog1 = 0.f;
    LAS float* TOT = (LAS float*)(lds + L_TOT);
    LAS float* EBC = (LAS float*)(lds + L_EBC);
    LAS float* OUT = (LAS float*)(lds + L_OUT);
#pragma unroll 1
    for (int sub = 0; sub < NSUB; ++sub) {
        const size_t row0 = row_base + (size_t)sub * 64;
        float bl0[8], bl1[8], g0[8], g1[8]; unsigned qraw[8];
        {
            const float* gp = T.GF + (row0 + 8 * seg) * 512 + hh * 128 + 2 * kp;
            const bf16* qp = T.QB + (row0 + 8 * seg) * 512 + hh * 128 + 2 * kp;
#pragma unroll
            for (int i = 0; i < 8; ++i) { const f32x2 gg = *(const f32x2*)(gp + (size_t)i * 512); g0[i] = gg.x; g1[i] = gg.y; if (MODE == 1) qraw[i] = *(const unsigned*)(qp + (size_t)i * 512); }
            float a0 = 0.f, a1 = 0.f;
#pragma unroll
            for (int i = 0; i < 8; ++i) { a0 += g0[i]; a1 += g1[i]; bl0[i] = a0; bl1[i] = a1; }
            TOT[seg * 128 + 2 * kp] = a0; TOT[seg * 128 + 2 * kp + 1] = a1;
#pragma unroll
            for (int i = 0; i < 2; ++i) {
                const int e = tid + i * 512, row = e >> 4, ch = e & 15;
                const v4u vv = *(const v4u*)(T.VB + (row0 + row) * 512 + hh * 128 + ch * 8);
                *(LAS v4u*)(lds + L_V + a_tr(row, ch)) = vv;
            }
        }
        __syncthreads();
        {
            float off0 = 0.f, off1 = 0.f, bc0 = 0.f, bc1 = 0.f, rr0 = 0.f, rr1 = 0.f;
#pragma unroll
            for (int s = 0; s < 8; ++s) {
                const float t0 = TOT[s * 128 + 2 * kp], t1 = TOT[s * 128 + 2 * kp + 1];
                if (s < seg) { off0 += t0; off1 += t1; }
                if (s < 4) { rr0 += t0; rr1 += t1; }
                bc0 += t0; bc1 += t1;
            }
            if (seg == 0) { EBC[2 * kp] = __expf(bc0); EBC[2 * kp + 1] = __expf(bc1); dlog0 += bc0; dlog1 += bc1; }
            const float c1a = __expf(-rr0), c1b = __expf(-rr1), c2a = __expf(rr0 - bc0), c2b = __expf(rr1 - bc1);
#pragma unroll
            for (int i = 0; i < 8; ++i) {
                const int row = 8 * seg + i;
                const float b0 = off0 + bl0[i], b1 = off1 + bl1[i];
                const float kk0 = 1.0f - __expf(g0[i]), kk1 = 1.0f - __expf(g1[i]);
                const float kt0 = kk0 * __expf(bc0 - b0), kt1 = kk1 * __expf(bc1 - b1);
                *(LAS unsigned*)(lds + L_KT + a_tr(row, kp >> 2) + (kp & 3) * 4) = pk2(kt0, kt1);
                if (MODE == 1) {
                    const float q0 = bf2f((unsigned short)(qraw[i] & 0xffff)), q1 = bf2f((unsigned short)(qraw[i] >> 16));
                    const float qt0 = q0 * __expf(b0), qt1 = q1 * __expf(b1);
                    *(LAS unsigned*)(lds + L_QT + a_qt(row, kp >> 1) + (kp & 1) * 4) = pk2(qt0, qt1);
                    *(LAS unsigned*)(lds + L_QH + a_row(row, kp >> 2) + (kp & 3) * 4) = pk2(qt0 * c1a, qt1 * c1b);
                    *(LAS unsigned*)(lds + L_KH + a_row(row, kp >> 2) + (kp & 3) * 4) = pk2(kt0 * c2a, kt1 * c2b);
                }
            }
        }
        __syncthreads();
        if (MODE == 1) {
            bf16x8 pX[2][2];
#pragma unroll
            for (int st = 0; st < 2; ++st) {
                if (st <= th) {
                    f32x16 X = {};
#pragma unroll
                    for (int k8 = 0; k8 < 8; ++k8) {
                        const bf16x8 af = *(const LAS bf16x8*)(lds + L_KH + a_row(32 * st + r32, 2 * k8 + hi));
                        const bf16x8 bfr = *(const LAS bf16x8*)(lds + L_QH + a_row(32 * th + r32, 2 * k8 + hi));
                        X = __builtin_amdgcn_mfma_f32_32x32x16_bf16(af, bfr, X, 0, 0, 0);
                    }
                    if (st == th) {
#pragma unroll
                        for (int r = 0; r < 16; ++r) X[r] = (crow(r, hi) <= r32) ? X[r] : 0.f;
                    }
                    pX[st][0] = pack8(X, 0); pX[st][1] = pack8(X, 8);
                } else { pX[st][0] = (bf16x8){0, 0, 0, 0, 0, 0, 0, 0}; pX[st][1] = pX[st][0]; }
            }
            f32x16 o = {};
#pragma unroll
            for (int kt = 0; kt < 4; ++kt)
#pragma unroll
                for (int s = 0; s < 2; ++s) {
                    const int row = 32 * th + r32, gq = 8 * kt + 4 * s + hi;
                    const v2u lo = *(const LAS v2u*)(lds + L_QT + a_qt(row, gq)), hh2 = *(const LAS v2u*)(lds + L_QT + a_qt(row, gq + 2));
                    const v4u aw = {lo.x, lo.y, hh2.x, hh2.y};
                    o = __builtin_amdgcn_mfma_f32_32x32x16_bf16(__builtin_bit_cast(bf16x8, aw), pack8(S[kt], 8 * s), o, 0, 0, 0);
                }
#pragma unroll
            for (int st = 0; st < 2; ++st) {
                if (st <= th) {
#pragma unroll
                    for (int ks = 0; ks < 2; ++ks) {
                        const int c = 4 * vt + 2 * ((lane >> 4) & 1) + ((lane & 3) >> 1);
                        const int rA = 32 * st + 16 * ks + 4 * hi + ((lane & 15) >> 2);
                        const s16x4 lo = tr_read(lds + L_V + a_tr(rA, c) + 8 * (lane & 1)), h2 = tr_read(lds + L_V + a_tr(rA + 8, c) + 8 * (lane & 1));
                        const bf16x8 vf = (bf16x8){lo[0], lo[1], lo[2], lo[3], h2[0], h2[1], h2[2], h2[3]};
                        o = __builtin_amdgcn_mfma_f32_32x32x16_bf16(pX[st][ks], vf, o, 0, 0, 0);
                    }
                }
            }
#pragma unroll
            for (int r = 0; r < 16; ++r) OUT[(32 * th + crow(r, hi)) * 132 + 32 * vt + r32] = o[r];
        }
#pragma unroll
        for (int kt = 0; kt < 4; ++kt) {
#pragma unroll
            for (int r = 0; r < 16; ++r) S[kt][r] *= EBC[32 * kt + crow(r, hi)];
#pragma unroll
            for (int ts = 0; ts < 4; ++ts) {
                const int rA = 16 * ts + 8 * hi + ((lane & 15) >> 2);
                const int ck = 4 * kt + 2 * ((lane >> 4) & 1) + ((lane & 3) >> 1), cv = 4 * vt + 2 * ((lane >> 4) & 1) + ((lane & 3) >> 1);
                const s16x4 ka = tr_read(lds + L_KT + a_tr(rA, ck) + 8 * (lane & 1)), kb = tr_read(lds + L_KT + a_tr(rA + 4, ck) + 8 * (lane & 1));
                const s16x4 va = tr_read(lds + L_V + a_tr(rA, cv) + 8 * (lane & 1)), vb = tr_read(lds + L_V + a_tr(rA + 4, cv) + 8 * (lane & 1));
                const bf16x8 kf = (bf16x8){ka[0], ka[1], ka[2], ka[3], kb[0], kb[1], kb[2], kb[3]};
                const bf16x8 vf = (bf16x8){va[0], va[1], va[2], va[3], vb[0], vb[1], vb[2], vb[3]};
                S[kt] = __builtin_amdgcn_mfma_f32_32x32x16_bf16(kf, vf, S[kt], 0, 0, 0);
            }
        }
        __syncthreads();
        if (MODE == 1) {
            const int t = tid >> 3, vs = tid & 7;
            float x[16]; float ss = 0.f;
#pragma unroll
            for (int i = 0; i < 16; ++i) { x[i] = OUT[t * 132 + 16 * vs + i]; ss += x[i] * x[i]; }
            ss += __shfl_xor(ss, 1); ss += __shfl_xor(ss, 2); ss += __shfl_xor(ss, 4);
            const float rs = 1.0f / sqrtf(ss * (1.0f / 128.0f) + 1e-5f);
            const size_t grow = row0 + t;
            const v4u gb0 = *(const v4u*)(T.GB + grow * 512 + hh * 128 + 16 * vs), gb1 = *(const v4u*)(T.GB + grow * 512 + hh * 128 + 16 * vs + 8);
            v4u o0, o1;
#pragma unroll
            for (int k = 0; k < 4; ++k) {
                const float n0 = T.norm_g[16 * vs + 2 * k], n1 = T.norm_g[16 * vs + 2 * k + 1], n2 = T.norm_g[16 * vs + 8 + 2 * k], n3 = T.norm_g[16 * vs + 8 + 2 * k + 1];
                o0[k] = pk2(x[2 * k] * rs * n0 * bf2f((unsigned short)(gb0[k] & 0xffff)), x[2 * k + 1] * rs * n1 * bf2f((unsigned short)(gb0[k] >> 16)));
                o1[k] = pk2(x[8 + 2 * k] * rs * n2 * bf2f((unsigned short)(gb1[k] & 0xffff)), x[8 + 2 * k + 1] * rs * n3 * bf2f((unsigned short)(gb1[k] >> 16)));
            }
            bf16* mp = T.MIX + grow * 1024 + 512 + hh * 128 + 16 * vs;
            *(v4u*)mp = o0; *(v4u*)(mp + 8) = o1;
        }
    }
    if (MODE == 0) {
        if (th == 0) {
            float* hl = T.PL + (size_t)uidx * 16384;
#pragma unroll
            for (int kt = 0; kt < 4; ++kt)
#pragma unroll
                for (int r = 0; r < 16; ++r) hl[(32 * kt + crow(r, hi)) * 128 + 32 * vt + r32] = S[kt][r];
        }
        if (seg == 0) { T.PD[(size_t)uidx * 128 + 2 * kp] = dlog0; T.PD[(size_t)uidx * 128 + 2 * kp + 1] = dlog1; }
    }
}
template <int MODE>
__device__ __forceinline__ void phase(LAS unsigned char* lds, const Tensors& T, int vcu, int G, int tid) {
    for (int u = vcu; u < NB * 4 * NSC; u += G) { const int sc = u % NSC, hh = (u / NSC) & 3, b = u / (NSC * 4); unit<MODE>(lds, T, b, hh, sc, tid); }
}
__device__ __forceinline__ void carry(const Tensors& T, float* sp, int gtid, int gthreads) {
    for (int i = gtid; i < NB * 4 * 16384; i += gthreads) {
        const int bh = i >> 14, e = i & 16383, k = e >> 7;
        float S = 0.f;
#pragma unroll 1
        for (int sc = 0; sc < NSC; ++sc) {
            const size_t u = (size_t)bh * NSC + sc;
            S = __expf(T.PD[u * 128 + k]) * S + T.PL[u * 16384 + e];
            if (sc + 1 < NSC) T.PS[(u + 1) * 16384 + e] = S; else sp[(size_t)bh * 16384 + e] = S;
        }
    }
}
__device__ __forceinline__ void sample_unit(LAS unsigned char* lds, const Tensors& T, const float* S0, float* Sout, int b, int hh, int tid) {
    LAS float* FK = (LAS float*)lds;
    LAS float* QQ = FK + 1024;
    LAS float* PART = QQ + 1024;
    LAS float* RS = PART + 4096;
    const size_t row0 = (size_t)MP + (size_t)b * 8;
    for (int i = tid; i < 1024; i += 512) { const int t = i >> 7, k = i & 127; FK[i] = __expf(T.GF[(row0 + t) * 512 + hh * 128 + k]); QQ[i] = bf2f(T.QB[(row0 + t) * 512 + hh * 128 + k]); }
    const int v = tid & 127, kq = tid >> 7;
    float S[32];
    const float* s0 = S0 + ((size_t)(b * 4 + hh) * 128 + 32 * kq) * 128 + v;
#pragma unroll
    for (int i = 0; i < 32; ++i) S[i] = s0[(size_t)i * 128];
    __syncthreads();
#pragma unroll 1
    for (int t = 0; t < 8; ++t) {
        const float iv = bf2f(T.VB[(row0 + t) * 512 + hh * 128 + v]);
        float po = 0.f;
#pragma unroll
        for (int i = 0; i < 32; ++i) { const float f = FK[t * 128 + 32 * kq + i]; S[i] = f * S[i] + (1.0f - f) * iv; po += S[i] * QQ[t * 128 + 32 * kq + i]; }
        PART[(kq * 8 + t) * 128 + v] = po;
    }
    float* so = Sout + ((size_t)(b * 4 + hh) * 128 + 32 * kq) * 128 + v;
#pragma unroll
    for (int i = 0; i < 32; ++i) so[(size_t)i * 128] = S[i];
    __syncthreads();
    {
        const int t = tid >> 6, l = tid & 63;
        const float a = PART[(0 * 8 + t) * 128 + l] + PART[(1 * 8 + t) * 128 + l] + PART[(2 * 8 + t) * 128 + l] + PART[(3 * 8 + t) * 128 + l];
        const float c = PART[(0 * 8 + t) * 128 + 64 + l] + PART[(1 * 8 + t) * 128 + 64 + l] + PART[(2 * 8 + t) * 128 + 64 + l] + PART[(3 * 8 + t) * 128 + 64 + l];
        float ss = a * a + c * c;
#pragma unroll
        for (int o = 1; o < 64; o <<= 1) ss += __shfl_xor(ss, o);
        const float rs = 1.0f / sqrtf(ss * (1.0f / 128.0f) + 1e-5f);
        const size_t grow = row0 + t;
        const float ga = bf2f(T.GB[grow * 512 + hh * 128 + l]), gc = bf2f(T.GB[grow * 512 + hh * 128 + 64 + l]);
        T.MIX[grow * 1024 + 512 + hh * 128 + l] = (bf16)f2bf(a * rs * T.norm_g[l] * ga);
        T.MIX[grow * 1024 + 512 + hh * 128 + 64 + l] = (bf16)f2bf(c * rs * T.norm_g[64 + l] * gc);
    }
    __syncthreads();
}
__device__ __forceinline__ void sample_phase(LAS unsigned char* lds, const Tensors& T, const float* S0, float* Sout, int vcu, int G, int tid) {
    for (int u = vcu; u < DB * 4; u += G) sample_unit(lds, T, S0, Sout, u >> 2, u & 3, tid);
}
}
namespace sa {
constexpr int NPART = 16;
constexpr int PROW = 68;
constexpr int PSTRIDE = 8 * 8 * PROW;
struct Tensors { const float* ck; const float* cv; const bf16* QA; const bf16* KA; const bf16* VA; const float* bs; float* part; };

__device__ __forceinline__ void load_row(const Tensors& T, int b, int e, int lane, float (&k)[8], float (&v)[8]) {
    if (e < WIN) {
        const float* kp = T.ck + ((size_t)b * WIN + e) * 512 + lane * 8; const float* vp = T.cv + ((size_t)b * WIN + e) * 512 + lane * 8;
        const f32x4 k0 = __builtin_nontemporal_load((const f32x4*)kp), k1 = __builtin_nontemporal_load((const f32x4*)kp + 1);
        const f32x4 v0 = __builtin_nontemporal_load((const f32x4*)vp), v1 = __builtin_nontemporal_load((const f32x4*)vp + 1);
#pragma unroll
        for (int i = 0; i < 4; ++i) { k[i] = k0[i]; k[4 + i] = k1[i]; v[i] = v0[i]; v[4 + i] = v1[i]; }
    } else {
        const size_t row = (size_t)MP + (size_t)b * 8 + (e - WIN);
        const v4u kk = *(const v4u*)(T.KA + row * 512 + lane * 8), vv = *(const v4u*)(T.VA + row * 512 + lane * 8);
#pragma unroll
        for (int i = 0; i < 4; ++i) { k[2 * i] = bf2f((unsigned short)(kk[i] & 0xffff)); k[2 * i + 1] = bf2f((unsigned short)(kk[i] >> 16)); v[2 * i] = bf2f((unsigned short)(vv[i] & 0xffff)); v[2 * i + 1] = bf2f((unsigned short)(vv[i] >> 16)); }
    }
}
__device__ __forceinline__ void unit(const Tensors& T, int b, int half, int tid) {
    const int lane = tid & 63, wid = __builtin_amdgcn_readfirstlane(tid >> 6), hh = lane >> 3;
    float q[8][8], acc[8][8], m[8], l[8];
#pragma unroll
    for (int t = 0; t < 8; ++t) {
        const v4u qq = *(const v4u*)(T.QA + ((size_t)MP + (size_t)b * 8 + t) * 512 + lane * 8);
#pragma unroll
        for (int i = 0; i < 4; ++i) { q[t][2 * i] = bf2f((unsigned short)(qq[i] & 0xffff)); q[t][2 * i + 1] = bf2f((unsigned short)(qq[i] >> 16)); }
#pragma unroll
        for (int i = 0; i < 8; ++i) acc[t][i] = 0.f;
        m[t] = -1e30f; l[t] = 0.f;
    }
    const int nrows = half == 0 ? 768 : 520;
#pragma unroll 1
    for (int n = wid; n < nrows; n += 16) {
        const int n2 = n + 8;
        const int e0 = half == 0 ? ((n >> 3) * 16 + (n & 7)) : (1536 + n);
        const bool has2 = n2 < nrows;
        const int e1 = has2 ? (half == 0 ? ((n2 >> 3) * 16 + (n2 & 7)) : (1536 + n2)) : e0;
        float k0[8], v0[8], k1[8], v1[8];
        load_row(T, b, e0, lane, k0, v0);
        load_row(T, b, e1, lane, k1, v1);
#pragma unroll
        for (int rr = 0; rr < 2; ++rr) {
            if (rr == 1 && !has2) break;
            const int e = rr == 0 ? e0 : e1;
#pragma unroll
            for (int t = 0; t < 8; ++t) {
                const int delta = WIN + t - e;
                if (delta < 0) continue;
                const int mult = (delta <= 128 ? 1 : 0) + (((delta & 3) == 0 && delta <= 512) ? 1 : 0) + (((delta & 15) == 0) ? 1 : 0);
                if (mult == 0) continue;
                float d = 0.f;
#pragma unroll
                for (int i = 0; i < 8; ++i) d += q[t][i] * (rr == 0 ? k0[i] : k1[i]);
                d += __shfl_xor(d, 1); d += __shfl_xor(d, 2); d += __shfl_xor(d, 4);
                const float s = d * LOG2E + T.bs[delta * 8 + hh];
                const float mn = fmaxf(m[t], s);
                const float corr = __builtin_amdgcn_exp2f(m[t] - mn), p = (float)mult * __builtin_amdgcn_exp2f(s - mn);
                l[t] = l[t] * corr + p;
#pragma unroll
                for (int i = 0; i < 8; ++i) acc[t][i] = acc[t][i] * corr + p * (rr == 0 ? v0[i] : v1[i]);
                m[t] = mn;
            }
        }
    }
    float* pp = T.part + ((size_t)b * NPART + half * 8 + wid) * PSTRIDE;
#pragma unroll
    for (int t = 0; t < 8; ++t) {
        float* o = pp + (t * 8 + hh) * PROW;
        *(f32x4*)(o + 8 * (lane & 7)) = (f32x4){acc[t][0], acc[t][1], acc[t][2], acc[t][3]};
        *(f32x4*)(o + 8 * (lane & 7) + 4) = (f32x4){acc[t][4], acc[t][5], acc[t][6], acc[t][7]};
        if ((lane & 7) == 0) { o[64] = m[t]; o[65] = l[t]; }
    }
}
__device__ __forceinline__ void phase(const Tensors& T, int vcu, int G, int tid) {
    for (int u = vcu; u < DB * 2; u += G) unit(T, u >> 1, u & 1, tid);
}
__device__ __forceinline__ void combine(const Tensors& T, const bf16* GA, bf16* MIX, int gtid, int gthreads) {
    for (int i = gtid; i < DB * 8 * 8 * 8; i += gthreads) {
        const int c8 = i & 7, h = (i >> 3) & 7, t = (i >> 6) & 7, b = i >> 9;
        const float* p0 = T.part + (size_t)b * NPART * PSTRIDE + (t * 8 + h) * PROW;
        float M = -1e30f;
#pragma unroll
        for (int p = 0; p < NPART; ++p) M = fmaxf(M, p0[(size_t)p * PSTRIDE + 64]);
        float L = 0.f; float o[8];
#pragma unroll
        for (int k = 0; k < 8; ++k) o[k] = 0.f;
#pragma unroll
        for (int p = 0; p < NPART; ++p) {
            const float* pp = p0 + (size_t)p * PSTRIDE;
            const float w = __builtin_amdgcn_exp2f(pp[64] - M);
            L += w * pp[65];
            const f32x4 a0 = *(const f32x4*)(pp + 8 * c8), a1 = *(const f32x4*)(pp + 8 * c8 + 4);
#pragma unroll
            for (int k = 0; k < 4; ++k) { o[k] += w * a0[k]; o[4 + k] += w * a1[k]; }
        }
        const float inv = 1.0f / L;
        const size_t row = (size_t)MP + (size_t)b * 8 + t;
        const v4u gg = *(const v4u*)(GA + row * 512 + h * 64 + 8 * c8);
        v4u w;
#pragma unroll
        for (int k = 0; k < 4; ++k) w[k] = pk2(o[2 * k] * inv * bf2f((unsigned short)(gg[k] & 0xffff)), o[2 * k + 1] * inv * bf2f((unsigned short)(gg[k] >> 16)));
        *(v4u*)(MIX + row * 1024 + h * 64 + 8 * c8) = w;
    }
}
__device__ __forceinline__ void copy_phase(const float* ck, const float* cv, float* kws, float* vws, int vcu, int G, int tid) {
    constexpr int CH_PER_B = 255, NCH = DB * CH_PER_B;
    for (int c = vcu; c < NCH; c += G) {
        const int b = c / CH_PER_B, r0 = (c - b * CH_PER_B) * 1024;
        const size_t base = (size_t)b * (WIN * 128) + r0 + tid;
        const f32x4 a0 = __builtin_nontemporal_load((const f32x4*)ck + base + 1024), a1 = __builtin_nontemporal_load((const f32x4*)ck + base + 1024 + 512);
        const f32x4 c0 = __builtin_nontemporal_load((const f32x4*)cv + base + 1024), c1 = __builtin_nontemporal_load((const f32x4*)cv + base + 1024 + 512);
        __builtin_nontemporal_store(a0, (f32x4*)kws + base); __builtin_nontemporal_store(a1, (f32x4*)kws + base + 512);
        __builtin_nontemporal_store(c0, (f32x4*)vws + base); __builtin_nontemporal_store(c1, (f32x4*)vws + base + 512);
    }
}
}
#ifndef MK_N_LAUNCHES
#define MK_N_LAUNCHES 1
#endif
constexpr int NPH = 7;
__global__ void __launch_bounds__(NWAVES * 64, 2) mk(Args args) {
    extern __shared__ __attribute__((aligned(16))) unsigned char lds[];
    Frame F;
    F.lds = (LAS unsigned char*)lds;
    F.MISC = (volatile LAS unsigned*)(F.lds + MISC_OFF);
    F.tid = threadIdx.x; F.lane = F.tid & 63; F.wave = __builtin_amdgcn_readfirstlane(F.tid >> 6);
    F.G = gridDim.x; { const int bx = blockIdx.x; F.vcu = (F.G % 8 == 0) ? (bx % 8) * (F.G / 8) + bx / 8 : bx; }
    unsigned char* ws = args.ws;
    F.ctl = (gu32*)(ws + WS_CTL);
    for (int u = F.tid; u < (LDS_BYTES - LDSCTL_OFF) / 4; u += NWAVES * 64) ((LAS unsigned*)(F.lds + LDSCTL_OFF))[u] = 0u;
    __syncthreads();
    XcdBarrier bar = xcd_barrier_post((unsigned*)(F.ctl + CW_BAR), F.MISC + 8);
    const int lo = args.ph_lo, hi = args.ph_hi;
#define IN(k) (lo <= (k) && (k) < hi)
#define BOTH(k) (IN(k) && IN((k) + 1))
    float* out = args.out;
    float* y = out;
    float* kwp = out + (size_t)MT * DM; float* vwp = kwp + (size_t)NB * WIN * 512;
    float* kws = vwp + (size_t)NB * WIN * 512; float* vws = kws + (size_t)DB * WIN * 512;
    float* sp = vws + (size_t)DB * WIN * 512; float* ss = sp + (size_t)NB * 4 * 128 * 128;
    const int gtid = F.vcu * (NWAVES * 64) + F.tid, gthreads = F.G * NWAVES * 64;

    if (IN(0)) { p0_prologue(F, args); if (BOTH(0)) xcd_barrier(bar); }
    if (IN(1)) {
        pg8::Gemm g{(const pg8::bf16_t*)(ws + WS_XB), (const pg8::bf16_t*)(ws + WS_WTIN), MT, DIN, DM};
        pg8::StaticOrder S; S.init(MT, DIN, F.G, (int)blockIdx.x);
        pg8::EpiInProj E{ws, out, 0};
        pg8::gemm_phase<pg8::EpiInProj, pg8::StaticOrder, PG8_ALIGN, PG8_SP2>(F.lds + RING_OFF, g, S, E);
        if (BOTH(1)) xcd_barrier(bar);
    }
    const attn::Tensors AT{(const bf16*)(ws + WS_QA), (const bf16*)(ws + WS_KA), (const bf16*)(ws + WS_VA), (bf16*)(ws + WS_OP), (float*)(ws + WS_LSE), (const float*)(ws + WS_BIAST)};
    const hg::Tensors HT{(const float*)(ws + WS_GF), (const bf16*)(ws + WS_QB), (const bf16*)(ws + WS_VB), (const bf16*)(ws + WS_GB), args.in[9], (bf16*)(ws + WS_MIX),
                         (float*)(ws + WS_HL), (float*)(ws + WS_HD), (float*)(ws + WS_HS)};
    const sa::Tensors ST{args.in[2], args.in[3], (const bf16*)(ws + WS_QA), (const bf16*)(ws + WS_KA), (const bf16*)(ws + WS_VA), (const float*)(ws + WS_BS), (float*)(ws + WS_SPART)};
    if (IN(2)) {
        sa::phase(ST, F.vcu, F.G, F.tid);
        hg::sample_phase(F.lds, HT, args.in[4], ss, F.vcu, F.G, F.tid);
        hg::phase<0>(F.lds, HT, F.vcu, F.G, F.tid);
        attn::phase(F.lds, AT, F.vcu, F.G, F.tid);
        sa::copy_phase(args.in[2], args.in[3], kws, vws, F.vcu, F.G, F.tid);
        if (BOTH(2)) xcd_barrier(bar);
    }
    if (IN(3)) {
        hg::carry(HT, sp, gtid, gthreads);
        attn::combine(AT, (const bf16*)(ws + WS_GA), (bf16*)(ws + WS_MIX), gtid, gthreads);
        sa::combine(ST, (const bf16*)(ws + WS_GA), (bf16*)(ws + WS_MIX), gtid, gthreads);
        if (BOTH(3)) xcd_barrier(bar);
    }
    if (IN(4)) { hg::phase<1>(F.lds, HT, F.vcu, F.G, F.tid); if (BOTH(4)) xcd_barrier(bar); }
    if (IN(5)) {
        pg8::Gemm g{(const pg8::bf16_t*)(ws + WS_MIX), (const pg8::bf16_t*)(ws + WS_WTOUT), MT, DM, DM};
        pg8::StaticOrder S; S.init(MT, DM, F.G, (int)blockIdx.x);
        pg8::EpiZ E{args.in[0], args.in[1], y};
        pg8::gemm_phase<pg8::EpiZ, pg8::StaticOrder, PG8_ALIGN, PG8_SP2>(F.lds + RING_OFF, g, S, E);
        if (BOTH(5)) xcd_barrier(bar);
    }
    if (IN(6)) {
        const int gw = F.vcu * NWAVES + F.wave, NGW = F.G * NWAVES;
        for (int m = gw; m < MT; m += NGW) ln_row_inplace(y + (size_t)m * DM, args.in[10], args.in[11], F.lane);
    }
#undef IN
#undef BOTH
}

extern "C" void kernel_launch(void* const* d_in, const int* in_sizes, int n_in, void* d_out, int out_size, void* d_ws, size_t ws_size, hipStream_t stream) {
    static int grid = 0;
    if (grid == 0) {
        if (n_in != 12 || ws_size < WS_END) { fprintf(stderr, "kernel_launch: unexpected n_in %d / ws %zu\n", n_in, ws_size); grid = -1; return; }
        int dev = 0, cus = 0;
        if (hipGetDevice(&dev) != hipSuccess || hipDeviceGetAttribute(&cus, hipDeviceAttributeMultiprocessorCount, dev) != hipSuccess) { grid = -1; return; }
        if (hipFuncSetAttribute((const void*)mk, hipFuncAttributeMaxDynamicSharedMemorySize, LDS_BYTES) != hipSuccess) { grid = -1; return; }
        (void)hipGetLastError();
        grid = cus;
    }
    if (grid < 0) return;
    (void)hipMemsetAsync((char*)d_ws + WS_CTL, 0, CTL_ZERO_BYTES, stream);
    Args a{};
    for (int i = 0; i < 12; ++i) a.in[i] = (const float*)d_in[i];
    a.out = (float*)d_out; a.ws = (unsigned char*)d_ws; a.dbg_h32 = 0; a.pad = 0;
#if MK_N_LAUNCHES == 1
    a.ph_lo = 0; a.ph_hi = NPH;
    hipLaunchKernelGGL(mk, dim3(grid), dim3(NWAVES * 64), LDS_BYTES, stream, a);
#else
    for (int p = 0; p < NPH; ++p) { a.ph_lo = p; a.ph_hi = p + 1; hipLaunchKernelGGL(mk, dim3(grid), dim3(NWAVES * 64), LDS_BYTES, stream, a); }
#endif
}
```

```cpp
#include <hip/hip_runtime.h>
#include <cstdio>
#include <cstdint>
#include <cmath>
#define MK_N_LAUNCHES 1
namespace pg8 {
#define PG8_LAS __attribute__((address_space(3)))
typedef unsigned short bf16_t;
typedef short bf16x8 __attribute__((ext_vector_type(8)));
typedef float f32x4 __attribute__((ext_vector_type(4)));
typedef unsigned u32x4 __attribute__((ext_vector_type(4)));
constexpr int BM = 256, BK = 64, HALF = 128, HTB = HALF * BK * 2  , STAGE_BYTES = 8 * HTB, NXCD = 8, WGM = 8;

__host__ __device__ __forceinline__ int lds_byte(int r, int c) { const int st = (r >> 4) * 2 + (c >> 5), rr = r & 15, cc = c & 31, ob = rr * 64 + cc * 2; return st * 1024 + (ob ^ (((ob >> 9) & 1) << 5)); }
__host__ __device__ __forceinline__ void stage_rc(int b, int& R, int& C) { const int st = b / 1024, sb = b % 1024, swz = sb ^ (((sb >> 9) & 1) << 5); R = (st >> 1) * 16 + swz / 64; C = (st & 1) * 32 + (swz % 64) / 2; }
__host__ __device__ __forceinline__ int perm32(int rho) { const int n = rho >> 4, i = rho & 15; return 8 * (i >> 2) + 4 * n + (i & 3); }

struct Unit { int pm, pn; };
struct Gemm { const bf16_t* A; const bf16_t* Bt; int M, N, K; };

struct StaticOrder {
    int nM, nN, nwg, G, c;
    __host__ __device__ void init(int M, int N, int G_, int c_) { nM = M / BM; nN = N / BM; nwg = nM * nN; G = G_; c = c_; }
    __host__ __device__ bool next(int i, Unit& u) const {
        const long L = (long)i * G + c; if (L >= nwg) return false;
        int wgid = (int)L; { const int q = nwg / NXCD, r = nwg % NXCD, xcd = wgid % NXCD, off = wgid / NXCD; wgid = (xcd < r ? xcd * (q + 1) : r * (q + 1) + (xcd - r) * q) + off; }
        const int nig = WGM * nN, gid = wgid / nig, fm = gid * WGM, gsz = (nM - fm) < WGM ? (nM - fm) : WGM;
        u.pm = fm + ((wgid % nig) % gsz); u.pn = (wgid % nig) / gsz; return true;
    }
    __device__ __forceinline__ void a_ready(const Unit&) const {}
    __device__ __forceinline__ void done(const Unit&) const {}
};

__device__ __forceinline__ unsigned cvt_pk_bf16(float lo, float hi) { unsigned r; asm volatile("v_cvt_pk_bf16_f32 %0, %1, %2" : "=v"(r) : "v"(lo), "v"(hi)); return r; }
typedef float f32x2 __attribute__((ext_vector_type(2)));
__device__ __forceinline__ f32x2 gelu_pk(f32x2 v) {
    const f32x2 av = __builtin_elementwise_abs(v), d = av * 0.2316418882f + 1.0f;
    f32x2 t; t.x = __builtin_amdgcn_rcpf(d.x); t.y = __builtin_amdgcn_rcpf(d.y);
    f32x2 q = t * 0.5307027145f + (-0.7265760135f); q = q * t + 0.7107068705f; q = q * t + (-0.142248368f); q = q * t + 0.127414796f; q = q * t;
    const f32x2 s = (v * v) * (-0.72134752044f);
    f32x2 e; e.x = __builtin_amdgcn_exp2f(s.x); e.y = __builtin_amdgcn_exp2f(s.y);
    const f32x2 m = v * (q * e), r = v - m;
    f32x2 o; o.x = v.x < 0.f ? m.x : r.x; o.y = v.y < 0.f ? m.y : r.y; return o;
}

template <int ACT  > struct EpiBf16 {
    static constexpr bool PERM = true, AFTER_DRAIN = false; static_assert(ACT == 0 || ACT == 1, "EpiBf16: ACT is 0 (none) or 1 (gelu_pk)");
    bf16_t* O; int ldc; const float* bias; int split_cols; size_t split_stride; float scale0;
    __device__ __forceinline__ void operator()(const f32x4 (&acc)[2][2][4][2], const Unit& u, int wr, int wc, int fr, int fq) const {
        const int row0 = u.pm * BM + wr * 64 + fr; int colt = u.pn * BM; bf16_t* base = O;
        float sc = 1.f; if (split_cols) { const int t = colt / split_cols; base += (size_t)t * split_stride; colt -= t * split_cols; if (t == 0) sc = scale0; }
        const int col0 = colt + wc * 32 + 8 * fq, bcol0 = u.pn * BM + wc * 32 + 8 * fq;
        f32x4 bv[2][2];
#pragma unroll
        for (int bj = 0; bj < 2; ++bj)
#pragma unroll
            for (int n = 0; n < 2; ++n) bv[bj][n] = bias ? *(const f32x4*)(bias + bcol0 + bj * HALF + 4 * n) : (f32x4){0.f, 0.f, 0.f, 0.f};
#pragma unroll
        for (int ai = 0; ai < 2; ++ai)
#pragma unroll
            for (int m = 0; m < 4; ++m) { bf16_t* rowp = base + (size_t)(row0 + ai * HALF + m * 16) * ldc + col0;
#pragma unroll
                for (int bj = 0; bj < 2; ++bj) { f32x4 v0 = acc[ai][bj][m][0] + bv[bj][0], v1 = acc[ai][bj][m][1] + bv[bj][1];
                    if (ACT == 1) { f32x2 a = gelu_pk((f32x2){v0[0], v0[1]}), b = gelu_pk((f32x2){v0[2], v0[3]}), c = gelu_pk((f32x2){v1[0], v1[1]}), d = gelu_pk((f32x2){v1[2], v1[3]});
                        v0 = (f32x4){a.x, a.y, b.x, b.y}; v1 = (f32x4){c.x, c.y, d.x, d.y}; }
                    v0 = v0 * sc; v1 = v1 * sc; u32x4 w; w.x = cvt_pk_bf16(v0[0], v0[1]); w.y = cvt_pk_bf16(v0[2], v0[3]); w.z = cvt_pk_bf16(v1[0], v1[1]); w.w = cvt_pk_bf16(v1[2], v1[3]);
                    *(u32x4*)(rowp + bj * HALF) = w; } }
    }
};

struct PanelStats {
    unsigned* xbuf;
    unsigned* cnt;
    unsigned* tmo;
    int ntn; float eps;
    unsigned code;
    __device__ __forceinline__ bool run(const f32x4 (&v)[2][2][4][2], const Unit& u, int wr, int wc, int fr, int fq, PG8_LAS unsigned char* lds, int wid, int lane) const {
        typedef float f32x2v __attribute__((ext_vector_type(2)));
        PG8_LAS f32x2v* P = (PG8_LAS f32x2v*)lds;
        PG8_LAS f32x2v* S = (PG8_LAS f32x2v*)(lds + 8192);
        PG8_LAS unsigned* flag = (PG8_LAS unsigned*)(lds + 8192 + 2048);
#pragma unroll
        for (int ai = 0; ai < 2; ++ai)
#pragma unroll
            for (int m = 0; m < 4; ++m) {
                float s = 0.f;
#pragma unroll
                for (int bj = 0; bj < 2; ++bj)
#pragma unroll
                    for (int n = 0; n < 2; ++n) { const f32x4 x = v[ai][bj][m][n]; s += (x[0] + x[1]) + (x[2] + x[3]); }
                s += __shfl_xor(s, 16); s += __shfl_xor(s, 32);
                const float mw = s * (1.0f / 64.0f); float q = 0.f;
#pragma unroll
                for (int bj = 0; bj < 2; ++bj)
#pragma unroll
                    for (int n = 0; n < 2; ++n) { const f32x4 d = v[ai][bj][m][n] - mw; q += (d[0] * d[0] + d[1] * d[1]) + (d[2] * d[2] + d[3] * d[3]); }
                q += __shfl_xor(q, 16); q += __shfl_xor(q, 32);
                if (fq == 0) P[(ai * HALF + wr * 64 + m * 16 + fr) * 4 + wc] = (f32x2v){mw, q};
            }
        asm volatile("s_waitcnt lgkmcnt(0)" ::: "memory"); __builtin_amdgcn_s_barrier(); asm volatile("" ::: "memory");
#if defined(BROKEN_EXCHANGE_NO_WAIT)
#warning BROKEN CONTROL BUILD: the row-statistics exchange does not wait; results are wrong by design
        if (blockIdx.x >= 64) { const long long t0_ = clock64(); while (clock64() - t0_ < 60000) __builtin_amdgcn_s_sleep(8); }
#endif
        const int row = wid * 32 + (lane & 31);
        if (lane < 32) {
            const f32x2v a = P[row * 4 + 0], b = P[row * 4 + 1], c = P[row * 4 + 2], d = P[row * 4 + 3];
            const float mt = (a.x + b.x + c.x + d.x) * 0.25f;
            const float da = a.x - mt, db = b.x - mt, dc = c.x - mt, dd = d.x - mt;
            const float m2 = (a.y + b.y) + (c.y + d.y) + 64.0f * ((da * da + db * db) + (dc * dc + dd * dd));
            unsigned long long* slot = (unsigned long long*)xbuf + ((size_t)(u.pm * BM + row) * 4 + u.pn);
            __hip_atomic_store(slot, ((unsigned long long)__float_as_uint(m2) << 32) | __float_as_uint(mt), __ATOMIC_RELAXED, __HIP_MEMORY_SCOPE_AGENT);
        }
        asm volatile("s_waitcnt vmcnt(0)" ::: "memory");
        if (lane == 0) __hip_atomic_fetch_add(cnt + 64 * u.pm, 1u, __ATOMIC_RELAXED, __HIP_MEMORY_SCOPE_AGENT);
        if (wid == 0) {
            bool dead = false; const unsigned long long t0 = __builtin_amdgcn_s_memrealtime(); const unsigned want = 8u * (unsigned)ntn;
            for (;;) {
#if defined(BROKEN_EXCHANGE_NO_WAIT)
                break;
#endif
                if ((unsigned)__builtin_amdgcn_readfirstlane(__hip_atomic_load(cnt + 64 * u.pm, __ATOMIC_RELAXED, __HIP_MEMORY_SCOPE_AGENT)) >= want) break;
                if (__builtin_amdgcn_s_memrealtime() - t0 > 2000000ull) {
                    if (lane == 0) { unsigned expect = 0u; __hip_atomic_compare_exchange_strong(tmo + 1, &expect, code | (unsigned)(u.pm & 0xff), __ATOMIC_RELAXED, __ATOMIC_RELAXED, __HIP_MEMORY_SCOPE_AGENT);
                                     __hip_atomic_store(tmo, 1u, __ATOMIC_RELAXED, __HIP_MEMORY_SCOPE_AGENT); }
                    dead = true; break; }
                __builtin_amdgcn_s_sleep(2);
            }
            __builtin_amdgcn_fence(__ATOMIC_ACQUIRE, "agent");
            if (lane == 0) flag[0] = dead ? 1u : 0u;
        }
        asm volatile("s_waitcnt vmcnt(0) lgkmcnt(0)" ::: "memory"); __builtin_amdgcn_s_barrier(); asm volatile("" ::: "memory");
        const bool bad = flag[0] != 0u;
        if (lane < 32) {
            const unsigned long long* slot = (const unsigned long long*)xbuf + (size_t)(u.pm * BM + row) * 4; float mt[4], m2[4]; float ms = 0.f;
#pragma unroll
            for (int t = 0; t < 4; ++t) { if (t < ntn) { const unsigned long long w = __hip_atomic_load(slot + t, __ATOMIC_RELAXED, __HIP_MEMORY_SCOPE_AGENT); mt[t] = __uint_as_float((unsigned)w); m2[t] = __uint_as_float((unsigned)(w >> 32)); } else { mt[t] = 0.f; m2[t] = 0.f; } ms += mt[t]; }
            const float mean = ms / (float)ntn; float q = 0.f;
#pragma unroll
            for (int t = 0; t < 4; ++t) if (t < ntn) { const float dm = mt[t] - mean; q += m2[t] + 256.0f * dm * dm; }
            S[row] = (f32x2v){mean, 1.0f / sqrtf(q / (256.0f * (float)ntn) + eps)};
        }
        asm volatile("s_waitcnt lgkmcnt(0)" ::: "memory"); __builtin_amdgcn_s_barrier(); asm volatile("" ::: "memory");
        return bad;
    }
};
struct EpiLnRes {
    static constexpr bool PERM = false, AFTER_DRAIN = true;
    const float* base; float* out; int ldc; const float* bias; PanelStats st; unsigned poison;
    __device__ __forceinline__ void fused(f32x4 (&acc)[2][2][4][2], const Unit& u, int wr, int wc, int fr, int fq, PG8_LAS unsigned char* lds, int wid, int lane) const {
        typedef float f32x2v __attribute__((ext_vector_type(2)));
        const PG8_LAS f32x2v* S = (const PG8_LAS f32x2v*)(lds + 8192);
        const int col0 = u.pn * BM + wc * 32 + 4 * fq;
#pragma unroll
        for (int bj = 0; bj < 2; ++bj)
#pragma unroll
            for (int n = 0; n < 2; ++n) { const f32x4 bv = bias ? *(const f32x4*)(bias + col0 + bj * HALF + n * 16) : (f32x4){0.f, 0.f, 0.f, 0.f};
#pragma unroll
                for (int ai = 0; ai < 2; ++ai)
#pragma unroll
                    for (int m = 0; m < 4; ++m) acc[ai][bj][m][n] += bv; }
        f32x4 pre[4][2][2];
#pragma unroll
        for (int m = 0; m < 4; ++m) { const size_t off = (size_t)(u.pm * BM + wr * 64 + m * 16 + fr) * ldc + col0;
#pragma unroll
            for (int bj = 0; bj < 2; ++bj)
#pragma unroll
                for (int n = 0; n < 2; ++n) pre[m][bj][n] = *(const f32x4*)(base + off + bj * HALF + n * 16); }
        const bool bad = st.run(acc, u, wr, wc, fr, fq, lds, wid, lane) || poison != 0u;
        const float qnan = __builtin_nanf("");
#pragma unroll
        for (int ai = 0; ai < 2; ++ai)
#pragma unroll
            for (int m = 0; m < 4; ++m) { const int r = ai * HALF + wr * 64 + m * 16 + fr; const f32x2v sr = S[r]; const size_t off = (size_t)(u.pm * BM + r) * ldc + col0;
#pragma unroll
                for (int bj = 0; bj < 2; ++bj)
#pragma unroll
                    for (int n = 0; n < 2; ++n) { const f32x4 bs = ai == 0 ? pre[m][bj][n] : *(const f32x4*)(base + off + bj * HALF + n * 16); f32x4 o = bs + (acc[ai][bj][m][n] - sr.x) * sr.y;
                        if (bad) o = (f32x4){qnan, qnan, qnan, qnan}; *(f32x4*)(out + off + bj * HALF + n * 16) = o; }
                if (m & 1) asm volatile("" ::: "memory"); }
    }
};
struct EpiLnResLn {
    static constexpr bool PERM = false, AFTER_DRAIN = true;
    const float* base; float* out; bf16_t* xn; int ldc; const float* bias; PanelStats st1, st2; unsigned poison;
    __device__ __forceinline__ void fused(f32x4 (&acc)[2][2][4][2], const Unit& u, int wr, int wc, int fr, int fq, PG8_LAS unsigned char* lds, int wid, int lane) const {
        typedef float f32x2v __attribute__((ext_vector_type(2))); typedef unsigned u32x2v __attribute__((ext_vector_type(2)));
        const PG8_LAS f32x2v* S = (const PG8_LAS f32x2v*)(lds + 8192);
        const int col0 = u.pn * BM + wc * 32 + 4 * fq;
#pragma unroll
        for (int bj = 0; bj < 2; ++bj)
#pragma unroll
            for (int n = 0; n < 2; ++n) { const f32x4 bv = bias ? *(const f32x4*)(bias + col0 + bj * HALF + n * 16) : (f32x4){0.f, 0.f, 0.f, 0.f};
#pragma unroll
                for (int ai = 0; ai < 2; ++ai)
#pragma unroll
                    for (int m = 0; m < 4; ++m) acc[ai][bj][m][n] += bv; }
        bool bad = st1.run(acc, u, wr, wc, fr, fq, lds, wid, lane) || poison != 0u;
        const float qnan = __builtin_nanf("");
#pragma unroll
        for (int ai = 0; ai < 2; ++ai)
#pragma unroll
            for (int m = 0; m < 4; ++m) { const int r = ai * HALF + wr * 64 + m * 16 + fr; const f32x2v sr = S[r]; const size_t off = (size_t)(u.pm * BM + r) * ldc + col0;
#pragma unroll
                for (int bj = 0; bj < 2; ++bj)
#pragma unroll
                    for (int n = 0; n < 2; ++n) { const f32x4 bs = *(const f32x4*)(base + off + bj * HALF + n * 16); acc[ai][bj][m][n] = bs + (acc[ai][bj][m][n] - sr.x) * sr.y; }
                asm volatile("" : "+v"(acc[ai][0][m][0]), "+v"(acc[ai][0][m][1]), "+v"(acc[ai][1][m][0]), "+v"(acc[ai][1][m][1]));
                if (m & 1) asm volatile("" ::: "memory"); }
        const bool bad1 = bad;
        bad = st2.run(acc, u, wr, wc, fr, fq, lds, wid, lane) || bad;
#pragma unroll
        for (int ai = 0; ai < 2; ++ai)
#pragma unroll
            for (int m = 0; m < 4; ++m) { const int r = ai * HALF + wr * 64 + m * 16 + fr; const f32x2v sr = S[r]; const size_t off = (size_t)(u.pm * BM + r) * ldc + col0;
#pragma unroll
                for (int bj = 0; bj < 2; ++bj)
#pragma unroll
                    for (int n = 0; n < 2; ++n) { const f32x4 x1 = acc[ai][bj][m][n]; *(f32x4*)(out + off + bj * HALF + n * 16) = bad1 ? (f32x4){qnan, qnan, qnan, qnan} : x1;
                        const f32x4 o = (x1 - sr.x) * sr.y; u32x2v w; w.x = cvt_pk_bf16(o[0], o[1]); w.y = cvt_pk_bf16(o[2], o[3]);
                        if (bad) { w.x = 0x7fc07fc0u; w.y = 0x7fc07fc0u; } *(u32x2v*)(xn + off + bj * HALF + n * 16) = w; }
                asm volatile("" ::: "memory"); }
    }
};

struct NoBg { static constexpr bool ACTIVE = false; static constexpr int BG_OPS = 0; __device__ __forceinline__ void preload() {} template <int SLOT> __device__ __forceinline__ void step() {} __device__ __forceinline__ void drain() {} };
template <class Epi, class Sched, bool ALIGN_EPI = false, bool SP2 = false, class Bg = NoBg>
__device__ __forceinline__ void gemm_phase(PG8_LAS unsigned char* lds, const Gemm g, const Sched& S, const Epi& E, Bg& bg) {
    static_assert(!Bg::ACTIVE || SP2, "background job: SP2 loop only");
    const int tid = threadIdx.x, wid = __builtin_amdgcn_readfirstlane(tid >> 6), lane = tid & 63, wr = wid >> 2, wc = wid & 3, fr = lane & 15, fq = lane >> 4;
    const int K = g.K, nt = K / BK;
    unsigned voffA[2], voffB[2];
#pragma unroll
    for (int i = 0; i < 2; ++i) { int R, C; stage_rc(tid * 16 + i * 8192, R, C); const int Rb = Epi::PERM ? ((R & ~31) + perm32(R & 31)) : R;
        voffA[i] = (unsigned)(R * K + C) * 2u; voffB[i] = (unsigned)(Rb * K + C) * 2u; }
    const size_t kstep = (size_t)(BK * 2);
    const size_t hstep = (size_t)HALF * K * 2;
    const size_t tstep = 2 * hstep;
    const unsigned ldsw = (unsigned)wid * 1024u;
    const int aoff = lds_byte(wr * 64 + fr, fq * 8), boff = lds_byte(wc * 32 + fr, fq * 8);
#define PG8_SA(b, h) (((b) * 2 + (h)) * HTB)
#define PG8_SB(b, h) ((4 + (b) * 2 + (h)) * HTB)
#define PG8_STAGE(bufoff, gbase, voff) do { _Pragma("unroll") for (int _i = 0; _i < 2; ++_i) \
        __builtin_amdgcn_global_load_lds((const unsigned*)((const char*)(gbase) + (voff)[_i]), (PG8_LAS unsigned*)(lds + (bufoff) + ldsw + _i * 8192), 16, 0, 0); } while (0)
#define PG8_LDA(dst, b, h) do { _Pragma("unroll") for (int m = 0; m < 4; ++m) _Pragma("unroll") for (int k = 0; k < 2; ++k) dst[m][k] = *(const PG8_LAS bf16x8*)(lds + PG8_SA(b, h) + aoff + m * 2048 + k * 1024); } while (0)
#define PG8_LDB(dst, b, h) do { _Pragma("unroll") for (int n = 0; n < 2; ++n) _Pragma("unroll") for (int k = 0; k < 2; ++k) dst[n][k] = *(const PG8_LAS bf16x8*)(lds + PG8_SB(b, h) + boff + n * 2048 + k * 1024); } while (0)
#define PG8_MMA(ai, bj, At, Bt) do { __builtin_amdgcn_s_setprio(1); _Pragma("unroll") for (int m = 0; m < 4; ++m) _Pragma("unroll") for (int n = 0; n < 2; ++n) _Pragma("unroll") for (int k = 0; k < 2; ++k) \
        acc[ai][bj][m][n] = __builtin_amdgcn_mfma_f32_16x16x32_bf16(Bt[n][k], At[m][k], acc[ai][bj][m][n], 0, 0, 0); __builtin_amdgcn_s_setprio(0); } while (0)
#define PG8_WAIT_V(n) asm volatile("s_waitcnt vmcnt(" #n ")" ::: "memory")
#define PG8_WAIT_L(n) asm volatile("s_waitcnt lgkmcnt(" #n ")" ::: "memory")
#define PG8_BAR __builtin_amdgcn_s_barrier()
#define PG8_SCHED __builtin_amdgcn_sched_barrier(0)
    Unit cur, nxt; int ui = 0;
    if (!S.next(0, cur)) return;
    f32x4 acc[2][2][4][2];
#pragma unroll
    for (int a = 0; a < 2; ++a)
#pragma unroll
        for (int b = 0; b < 2; ++b)
#pragma unroll
            for (int m = 0; m < 4; ++m)
#pragma unroll
                for (int n = 0; n < 2; ++n) acc[a][b][m][n] = (f32x4){0.f, 0.f, 0.f, 0.f};
    bf16x8 At[4][2], B0[2][2], B1[2][2];
    const char* cA = (const char*)g.A + (size_t)cur.pm * tstep; const char* cB = (const char*)g.Bt + (size_t)cur.pn * tstep;
    S.a_ready(cur);
    bg.preload();
    if constexpr (SP2) {
        PG8_STAGE(PG8_SB(0, 0), cB, voffB); PG8_STAGE(PG8_SB(0, 1), cB + hstep, voffB); PG8_STAGE(PG8_SA(0, 0), cA, voffA); PG8_STAGE(PG8_SA(0, 1), cA + hstep, voffA);
        if (wr == 1) PG8_BAR;
        PG8_WAIT_V(2); PG8_BAR;
        PG8_STAGE(PG8_SB(1, 0), cB + kstep, voffB); PG8_STAGE(PG8_SA(1, 0), cA + kstep, voffA); PG8_STAGE(PG8_SB(1, 1), cB + hstep + kstep, voffB);
        PG8_WAIT_V(6); PG8_BAR;
    } else {
        PG8_STAGE(PG8_SB(0, 0), cB, voffB); PG8_STAGE(PG8_SA(0, 0), cA, voffA); PG8_STAGE(PG8_SB(0, 1), cB + hstep, voffB); PG8_STAGE(PG8_SA(0, 1), cA + hstep, voffA);
        if (wr == 1) PG8_BAR;
        PG8_WAIT_V(4); PG8_BAR;
        PG8_STAGE(PG8_SB(1, 0), cB + kstep, voffB); PG8_STAGE(PG8_SA(1, 0), cA + kstep, voffA); PG8_STAGE(PG8_SB(1, 1), cB + hstep + kstep, voffB);
        PG8_WAIT_V(6); PG8_BAR;
    }
    for (;;) {
        const bool has_next = S.next(ui + 1, nxt);
        const char* nA = has_next ? (const char*)g.A + (size_t)nxt.pm * tstep : cA; const char* nB = has_next ? (const char*)g.Bt + (size_t)nxt.pn * tstep : cB;
        for (int t = 0; t < nt; t += 2) {
            const bool last = (t == nt - 2);
            const char* a1 = cA + (size_t)(t + 1) * kstep;
            const char* a2 = last ? nA : cA + (size_t)(t + 2) * kstep; const char* b2 = last ? nB : cB + (size_t)(t + 2) * kstep;
            const char* a3 = a2 + kstep; const char* b3 = b2 + kstep;
            if (last && has_next) S.a_ready(nxt);
            if constexpr (SP2) {
            PG8_LDB(B0, 0, 0); PG8_LDB(B1, 0, 1); PG8_SCHED; PG8_LDA(At, 0, 0); PG8_STAGE(PG8_SA(1, 1), a1 + hstep, voffA);
            bg.template step<0>(); if constexpr (Bg::BG_OPS == 4) { PG8_WAIT_V(16); } else if constexpr (Bg::BG_OPS == 2) { PG8_WAIT_V(12); } else { PG8_WAIT_V(8); } PG8_WAIT_L(0); PG8_BAR; PG8_MMA(0, 0, At, B0); PG8_MMA(0, 1, At, B1); PG8_BAR; PG8_SCHED;
            PG8_LDA(At, 0, 1); PG8_STAGE(PG8_SB(0, 0), b2, voffB); PG8_STAGE(PG8_SB(0, 1), b2 + hstep, voffB); PG8_STAGE(PG8_SA(0, 0), a2, voffA);
            bg.template step<1>(); if constexpr (Bg::BG_OPS == 4) { PG8_WAIT_V(16); } else if constexpr (Bg::BG_OPS == 2) { PG8_WAIT_V(12); } else { PG8_WAIT_V(8); } PG8_WAIT_L(0); PG8_BAR; PG8_MMA(1, 0, At, B0); PG8_MMA(1, 1, At, B1); PG8_BAR; PG8_SCHED;
            PG8_LDB(B0, 1, 0); PG8_LDB(B1, 1, 1); PG8_SCHED; PG8_LDA(At, 1, 0); PG8_STAGE(PG8_SA(0, 1), a2 + hstep, voffA);
            bg.template step<0>(); if constexpr (Bg::BG_OPS == 4) { PG8_WAIT_V(16); } else if constexpr (Bg::BG_OPS == 2) { PG8_WAIT_V(12); } else { PG8_WAIT_V(8); } PG8_WAIT_L(0); PG8_BAR; PG8_MMA(0, 0, At, B0); PG8_MMA(0, 1, At, B1); PG8_BAR; PG8_SCHED;
            PG8_LDA(At, 1, 1); PG8_STAGE(PG8_SB(1, 0), b3, voffB); PG8_STAGE(PG8_SB(1, 1), b3 + hstep, voffB); PG8_STAGE(PG8_SA(1, 0), a3, voffA);
            bg.template step<1>(); if constexpr (Bg::BG_OPS == 4) { PG8_WAIT_V(16); } else if constexpr (Bg::BG_OPS == 2) { PG8_WAIT_V(12); } else { PG8_WAIT_V(8); } PG8_WAIT_L(0); PG8_BAR; PG8_MMA(1, 0, At, B0); PG8_MMA(1, 1, At, B1); PG8_BAR; PG8_SCHED;
            } else {
            PG8_LDB(B0, 0, 0); PG8_SCHED; PG8_LDA(At, 0, 0); PG8_STAGE(PG8_SA(1, 1), a1 + hstep, voffA);
            PG8_WAIT_L(8); PG8_BAR; PG8_WAIT_L(0); PG8_MMA(0, 0, At, B0); PG8_BAR; PG8_SCHED;
            PG8_LDB(B1, 0, 1); PG8_STAGE(PG8_SB(0, 0), b2, voffB);
            PG8_BAR; PG8_WAIT_L(0); PG8_MMA(0, 1, At, B1); PG8_BAR;
            PG8_LDA(At, 0, 1); PG8_STAGE(PG8_SA(0, 0), a2, voffA);
            PG8_BAR; PG8_WAIT_L(0); PG8_MMA(1, 0, At, B0); PG8_BAR; PG8_SCHED;
            PG8_STAGE(PG8_SB(0, 1), b2 + hstep, voffB);
            PG8_WAIT_V(6); PG8_BAR; PG8_MMA(1, 1, At, B1); PG8_BAR;
            PG8_LDB(B0, 1, 0); PG8_SCHED; PG8_LDA(At, 1, 0); PG8_STAGE(PG8_SA(0, 1), a2 + hstep, voffA);
            PG8_WAIT_L(8); PG8_BAR; PG8_WAIT_L(0); PG8_MMA(0, 0, At, B0); PG8_BAR; PG8_SCHED;
            PG8_LDB(B1, 1, 1); PG8_STAGE(PG8_SB(1, 0), b3, voffB);
            PG8_BAR; PG8_WAIT_L(0); PG8_MMA(0, 1, At, B1); PG8_BAR;
            PG8_LDA(At, 1, 1); PG8_STAGE(PG8_SA(1, 0), a3, voffA);
            PG8_BAR; PG8_WAIT_L(0); PG8_MMA(1, 0, At, B0); PG8_BAR; PG8_SCHED;
            PG8_STAGE(PG8_SB(1, 1), b3 + hstep, voffB);
            PG8_WAIT_V(6); PG8_BAR; PG8_MMA(1, 1, At, B1); PG8_BAR;
            }
        }
        if constexpr (ALIGN_EPI) { if (wr == 0) PG8_BAR; }
        if constexpr (!Epi::AFTER_DRAIN) { E(acc, cur, wr, wc, fr, fq); S.done(cur); }
        if (!has_next) break;
#pragma unroll
        for (int a = 0; a < 2; ++a)
#pragma unroll
            for (int b = 0; b < 2; ++b)
#pragma unroll
                for (int m = 0; m < 4; ++m)
#pragma unroll
                    for (int n = 0; n < 2; ++n) acc[a][b][m][n] = (f32x4){0.f, 0.f, 0.f, 0.f};
        cur = nxt; cA = nA; cB = nB; ++ui;
        if constexpr (ALIGN_EPI) { if (wr == 1) PG8_BAR; }
    }
    bg.drain();
    PG8_WAIT_V(0);
    if constexpr (!ALIGN_EPI) { if (wr == 0) PG8_BAR; }
    PG8_BAR;
    if constexpr (Epi::AFTER_DRAIN) { E.fused(acc, cur, wr, wc, fr, fq, lds, wid, lane); S.done(cur); }
#undef PG8_SA
#undef PG8_SB
#undef PG8_STAGE
#undef PG8_LDA
#undef PG8_LDB
#undef PG8_MMA
#undef PG8_WAIT_V
#undef PG8_WAIT_L
#undef PG8_BAR
#undef PG8_SCHED
}
}
#ifndef PG8_SP2
#define PG8_SP2 true
#endif
#ifndef PG8_ALIGN
#define PG8_ALIGN true
#endif
constexpr int NWAVES = 8;
constexpr int MP = 32768, MS = 1024, MT = MP + MS;
constexpr int SEQ = 8192, NB = 4, DB = 128, DSEQ = 8, WIN = 2048;
constexpr int DM = 1024, DIN = 4096;
constexpr float LN_EPS = 1e-5f;
constexpr float ALPHA_F = 1.189207115002721f;
constexpr float LOG2E = 1.4426950408889634f;
constexpr size_t MiB = 1u << 20;
constexpr size_t WS_CTL = 0, CTL_ZERO_BYTES = 1 * MiB;
constexpr size_t WS_WTIN = 2 * MiB, WS_WTOUT = 10 * MiB, WS_LBV = 12 * MiB, WS_BIAST = 12 * MiB + 4096, WS_BS = 12 * MiB + 32768;
constexpr size_t WS_XB = 560 * MiB;
constexpr size_t SEG_STRIDE = 36 * MiB;
constexpr size_t WS_QA = 60 * MiB, WS_KA = WS_QA + SEG_STRIDE, WS_VA = WS_QA + 2 * SEG_STRIDE, WS_GA = WS_QA + 3 * SEG_STRIDE, WS_QB = WS_QA + 4 * SEG_STRIDE, WS_VB = WS_QA + 6 * SEG_STRIDE, WS_GB = WS_QA + 7 * SEG_STRIDE;
constexpr size_t WS_GF = 348 * MiB, WS_MIX = 420 * MiB, WS_OP = 1404 * MiB  , WS_LSE = 552 * MiB;
constexpr size_t WS_HL = 636 * MiB, WS_HD = 654 * MiB, WS_HS = 656 * MiB;
constexpr size_t WS_H32 = 700 * MiB, WS_ATTN32 = 1260 * MiB, WS_OG32 = 1332 * MiB, WS_SPART = 1500 * MiB  , WS_DUMMY = 1572 * MiB  , WS_END = 1584 * MiB;
constexpr int CW_TMO = 0, CW_CODE = 1, CW_BAR = 4096;
constexpr int RING_OFF = 0, RING_BYTES = 131072;
constexpr int LDSCTL_OFF = RING_BYTES, MISC_OFF = LDSCTL_OFF + 320;
constexpr int LDS_BYTES = 147456;

#define GAS __attribute__((address_space(1)))
#define LAS __attribute__((address_space(3)))
typedef unsigned short bf16;
typedef unsigned v4u __attribute__((ext_vector_type(4)));
typedef unsigned v2u __attribute__((ext_vector_type(2)));
typedef float f32x4 __attribute__((ext_vector_type(4)));
typedef short bf16x8 __attribute__((ext_vector_type(8)));
typedef GAS unsigned gu32;
#define RLX_AGENT __ATOMIC_RELAXED, __HIP_MEMORY_SCOPE_AGENT
#define LDS_WAIT() asm volatile("s_waitcnt lgkmcnt(0)" ::: "memory")
#define VM_WAIT() asm volatile("s_waitcnt vmcnt(0)" ::: "memory")
__device__ __forceinline__ unsigned f2bf(float f) { unsigned u = __builtin_bit_cast(unsigned, f); return (u + 0x7fffu + ((u >> 16) & 1u)) >> 16; }
__device__ __forceinline__ unsigned pk2(float lo, float hi) { return f2bf(lo) | (f2bf(hi) << 16); }
__device__ __forceinline__ float bf2f(unsigned short b) { return __builtin_bit_cast(float, (unsigned)b << 16); }
__device__ __forceinline__ float fast_sigmoid(float x) { return __builtin_amdgcn_rcpf(1.0f + __expf(-x)); }
__device__ __forceinline__ float fast_silu(float x) { return x * fast_sigmoid(x); }

namespace pg8 {
struct EpiInProj {
    static constexpr bool PERM = true, AFTER_DRAIN = false;
    unsigned char* ws; float* out; int dbg;
    __device__ __forceinline__ void operator()(const f32x4 (&acc)[2][2][4][2], const Unit& u, int wr, int wc, int fr, int fq) const {
        const int seg = u.pn >> 1;
        const int cs0 = (u.pn & 1) * 256 + wc * 32 + 8 * fq;
        const int row0 = u.pm * BM + wr * 64 + fr;
        const bool is_sample = u.pm >= 128;
        const bool win = (seg == 1 || seg == 2) && (is_sample || ((u.pm & 31) >= 24));
        float* wbase = out + (size_t)MT * DM + (is_sample ? (size_t)2 * NB * WIN * 512 + (seg == 2 ? (size_t)DB * WIN * 512 : 0) : (seg == 2 ? (size_t)NB * WIN * 512 : 0));
        bf16_t* ob = (bf16_t*)(ws + WS_QA + (size_t)seg * SEG_STRIDE);
        float* GF = (float*)(ws + WS_GF); const float* lbv = (const float*)(ws + WS_LBV); float* H32 = (float*)(ws + WS_H32);
#pragma unroll
        for (int ai = 0; ai < 2; ++ai)
#pragma unroll
            for (int m = 0; m < 4; ++m) {
                const int row = row0 + ai * HALF + m * 16;
                size_t wrow = 0;
                if (win) { if (is_sample) { const int rs = row - 32768; wrow = (size_t)(rs >> 3) * 2048 + 2040 + (rs & 7); } else { wrow = (size_t)(row >> 13) * 2048 + ((row & 8191) - 6144); } }
#pragma unroll
                for (int bj = 0; bj < 2; ++bj) {
                    const int cs = cs0 + bj * HALF;
                    f32x4 v0 = acc[ai][bj][m][0], v1 = acc[ai][bj][m][1];
                    if (dbg) { float* hp = H32 + (size_t)row * 4096 + seg * 512 + cs; *(f32x4*)hp = v0; *(f32x4*)(hp + 4) = v1; }
                    if (win) { float* wp = wbase + wrow * 512 + cs; *(f32x4*)wp = v0; *(f32x4*)(wp + 4) = v1; }
                    if (seg == 5) {
                        const f32x4 l0 = *(const f32x4*)(lbv + cs), l1 = *(const f32x4*)(lbv + cs + 4);
                        f32x4 g0, g1;
#pragma unroll
                        for (int i = 0; i < 4; ++i) { g0[i] = __logf(l0[i] + (1.0f - l0[i]) * fast_sigmoid(v0[i])); g1[i] = __logf(l1[i] + (1.0f - l1[i]) * fast_sigmoid(v1[i])); }
                        float* gp = GF + (size_t)row * 512 + cs; *(f32x4*)gp = g0; *(f32x4*)(gp + 4) = g1;
                    } else {
                        if (seg == 0) { v0 = v0 * 0.125f; v1 = v1 * 0.125f; }
                        else if (seg == 3 || seg == 7) {
#pragma unroll
                            for (int i = 0; i < 4; ++i) { v0[i] = fast_silu(v0[i]); v1[i] = fast_silu(v1[i]); }
                        } else if (seg == 4) {
#pragma unroll
                            for (int i = 0; i < 4; ++i) { v0[i] = fast_silu(v0[i]) * 0.08838834764831845f; v1[i] = fast_silu(v1[i]) * 0.08838834764831845f; }
                        }
                        u32x4 w; w.x = cvt_pk_bf16(v0[0], v0[1]); w.y = cvt_pk_bf16(v0[2], v0[3]); w.z = cvt_pk_bf16(v1[0], v1[1]); w.w = cvt_pk_bf16(v1[2], v1[3]);
                        *(u32x4*)(ob + (size_t)row * 512 + cs) = w;
                    }
                }
            }
    }
};
struct EpiZ {
    static constexpr bool PERM = true, AFTER_DRAIN = false;
    const float* xp; const float* xs; float* out;
    __device__ __forceinline__ void operator()(const f32x4 (&acc)[2][2][4][2], const Unit& u, int wr, int wc, int fr, int fq) const {
        const int row0 = u.pm * BM + wr * 64 + fr, col0 = u.pn * BM + wc * 32 + 8 * fq;
        const float* xb = (u.pm >= 128) ? (xs - (size_t)32768 * 1024) : xp;
#pragma unroll
        for (int ai = 0; ai < 2; ++ai)
#pragma unroll
            for (int m = 0; m < 4; ++m) {
                const size_t off = (size_t)(row0 + ai * HALF + m * 16) * 1024 + col0;
#pragma unroll
                for (int bj = 0; bj < 2; ++bj) {
                    const f32x4 x0 = *(const f32x4*)(xb + off + bj * HALF), x1 = *(const f32x4*)(xb + off + bj * HALF + 4);
                    *(f32x4*)(out + off + bj * HALF) = acc[ai][bj][m][0] + x0 * 1.189207115002721f;
                    *(f32x4*)(out + off + bj * HALF + 4) = acc[ai][bj][m][1] + x1 * 1.189207115002721f;
                }
            }
    }
};
template <int NPS>
struct CopyBg {
    static constexpr bool ACTIVE = true;
    static constexpr int BG_OPS = 2 * NPS;
    static constexpr unsigned NIT_T = 128u * 4080u, NIT = 2u * NIT_T;
    const float* ck; const float* cv; float* kws; float* vws;
    unsigned base, stride, first;
    unsigned sp; unsigned lane16;
    f32x4 b00, b01, b10, b11;
    __device__ __forceinline__ void init(const float* ck_, const float* cv_, float* kws_, float* vws_, unsigned base_, int G, int blk, int wave, int lane_) {
        ck = ck_; cv = cv_; kws = kws_; vws = vws_; base = base_; stride = (unsigned)G * 8u * NPS;
        first = (unsigned)__builtin_amdgcn_readfirstlane((blk * 8 + wave) * NPS); sp = 0u; lane16 = (unsigned)lane_ * 16u;
    }
    __device__ __forceinline__ unsigned long long addr_of(unsigned s, int j, bool dst) const {
        unsigned i = base + s * stride + first + (unsigned)j; i = i < NIT ? i : NIT - 1u;
        const bool isv = i >= NIT_T; const unsigned ii = isv ? i - NIT_T : i; const unsigned b = ii / 4080u, r = ii - b * 4080u;
        const unsigned long long off = ((unsigned long long)b * 262144ull + (unsigned long long)r * 64ull + (dst ? 0ull : 1024ull)) * 16ull;
        const unsigned long long p = (unsigned long long)(dst ? (isv ? (const float*)vws : (const float*)kws) : (isv ? cv : ck)) + off;
        const unsigned lo = (unsigned)__builtin_amdgcn_readfirstlane((int)(unsigned)p), hi = (unsigned)__builtin_amdgcn_readfirstlane((int)(unsigned)(p >> 32));
        return ((unsigned long long)hi << 32) | lo;
    }
#define CPBG_LD(reg, s, j) asm volatile("global_load_dwordx4 %0, %1, %2 nt" : "=&v"(reg) : "v"(lane16), "s"(addr_of((s), (j), false)) : "memory")
#define CPBG_ST(reg, s, j) asm volatile("global_store_dwordx4 %0, %1, %2 nt" :: "v"(lane16), "v"(reg), "s"(addr_of((s), (j), true)) : "memory")
    __device__ __forceinline__ void preload() { CPBG_LD(b00, 0u, 0); if (NPS == 2) CPBG_LD(b01, 0u, 1); CPBG_LD(b10, 1u, 0); if (NPS == 2) CPBG_LD(b11, 1u, 1); }
    template <int SLOT> __device__ __forceinline__ void step() {
        if (NPS == 2) asm volatile("s_waitcnt vmcnt(12)" ::: "memory"); else asm volatile("s_waitcnt vmcnt(10)" ::: "memory");
        if (SLOT == 0) { CPBG_ST(b00, sp, 0); if (NPS == 2) CPBG_ST(b01, sp, 1); CPBG_LD(b00, sp + 2u, 0); if (NPS == 2) CPBG_LD(b01, sp + 2u, 1); }
        else           { CPBG_ST(b10, sp, 0); if (NPS == 2) CPBG_ST(b11, sp, 1); CPBG_LD(b10, sp + 2u, 0); if (NPS == 2) CPBG_LD(b11, sp + 2u, 1); }
        ++sp;
    }
    __device__ __forceinline__ void drain() {
        asm volatile("s_waitcnt vmcnt(0)" ::: "memory");
        CPBG_ST(b00, sp, 0); if (NPS == 2) CPBG_ST(b01, sp, 1); CPBG_ST(b10, sp + 1u, 0); if (NPS == 2) CPBG_ST(b11, sp + 1u, 1);
    }
#undef CPBG_LD
#undef CPBG_ST
};
}

#define XB_TMO      128
#define XB_XCNT(j)  (256  + 64 * (j))
#define XB_XSUB(j)  (1280 + 64 * (j))
#define XB_XGEN(j)  (2304 + 64 * (j))
#define XB_TOP      3328
#define XB_TOPGEN   3392
#define XCD_BAR_WORDS 3456
#define XB_SPIN_CAP (1u << 18)
__device__ __forceinline__ unsigned xb_ld(unsigned* p)              { return __hip_atomic_load(p, __ATOMIC_RELAXED, __HIP_MEMORY_SCOPE_AGENT); }
__device__ __forceinline__ unsigned xb_add(unsigned* p, unsigned v) { return __hip_atomic_fetch_add(p, v, __ATOMIC_RELAXED, __HIP_MEMORY_SCOPE_AGENT); }
__device__ __forceinline__ unsigned xb_xcc_id() { return (unsigned)__builtin_amdgcn_s_getreg((3 << 11) | 20) & 0xFu; }
#define XB_SPIN(cond, bar) do { unsigned _sp = 0; while (cond) { __builtin_amdgcn_s_sleep(1); \
    if ((++_sp & 255u) == 0u) { if (xb_ld(&(bar)[XB_TMO])) break; if (_sp > XB_SPIN_CAP) { atomicAdd(&(bar)[XB_TMO], 1u); break; } } } } while (0)
struct XcdBarrier { unsigned* bar; unsigned x; volatile LAS unsigned* st; };
__device__ __forceinline__ XcdBarrier xcd_barrier_post(unsigned* bar, volatile LAS unsigned* st) {
    XcdBarrier b; b.bar = bar; b.x = xb_xcc_id(); b.st = st;
    if (threadIdx.x == 0) (void)xb_add(&bar[XB_XCNT(b.x)], 1u);
    return b;
}
__device__ __forceinline__ void xcd_barrier_complete(unsigned* bar, unsigned x, unsigned& nloc, unsigned& nx) {
    const unsigned G = gridDim.x * gridDim.y * gridDim.z;
    unsigned sum, cnt, mine, sp = 0u;
    for (;;) {
        sum = 0u; cnt = 0u; mine = 0u;
#pragma unroll
        for (unsigned j = 0; j < 16; ++j) { const unsigned c = xb_ld(&bar[XB_XCNT(j)]); sum += c; cnt += (c > 0u) ? 1u : 0u; mine = (j == x) ? c : mine; }
        if (sum == G) break;
        __builtin_amdgcn_s_sleep(1);
        if ((++sp & 255u) == 0u) { if (xb_ld(&bar[XB_TMO])) break; if (sp > XB_SPIN_CAP) { atomicAdd(&bar[XB_TMO], 1u); break; } }
    }
    nloc = mine > 0u ? mine : 1u; nx = cnt > 0u ? cnt : 1u;
}
__device__ __forceinline__ void xcd_barrier(const XcdBarrier& b) {
    asm volatile("s_waitcnt vmcnt(0)" ::: "memory");
    __syncthreads();
    if (threadIdx.x == 0) {
        unsigned* bar = b.bar;
        __builtin_amdgcn_s_waitcnt(0);
        unsigned nloc = b.st[0], nx = b.st[1];
        if (nloc == 0u) { xcd_barrier_complete(bar, b.x, nloc, nx); b.st[0] = nloc; b.st[1] = nx; }
        const unsigned old = xb_add(&bar[XB_XSUB(b.x)], 1u);
        const unsigned gen = old / nloc;
        if (old + 1u == (gen + 1u) * nloc) {
            __builtin_amdgcn_fence(__ATOMIC_RELEASE, "agent");
            asm volatile("s_waitcnt vmcnt(0)" ::: "memory");
            const unsigned og = xb_add(&bar[XB_TOP], 1u);
            const unsigned tg = og / nx;
            if (og + 1u == (tg + 1u) * nx) xb_add(&bar[XB_TOPGEN], 1u);
            else XB_SPIN(xb_ld(&bar[XB_TOPGEN]) == tg, bar);
            __builtin_amdgcn_fence(__ATOMIC_ACQUIRE, "agent");
            xb_add(&bar[XB_XGEN(b.x)], 1u);
            asm volatile("s_waitcnt vmcnt(0)" ::: "memory");
        } else {
            XB_SPIN(xb_ld(&bar[XB_XGEN(b.x)]) == gen, bar);
            __builtin_amdgcn_fence(__ATOMIC_ACQUIRE, "agent");
            asm volatile("s_waitcnt vmcnt(0)" ::: "memory");
        }
    }
    __syncthreads();
}

struct Frame {
    LAS unsigned char* lds;
    volatile LAS unsigned* MISC;
    gu32* ctl;
    int tid, lane, wave, vcu, G;
};
struct Args {
    const float* in[12]; float* out; unsigned char* ws; int ph_lo, ph_hi; int dbg_h32; int pad;
};

__device__ __forceinline__ float wave_sum(float v) {
#pragma unroll
    for (int o = 1; o < 64; o <<= 1) v += __shfl_xor(v, o);
    return v;
}
__device__ __forceinline__ void p0_transpose_item(const float* W, int K, int N, bf16* WT, LAS float* scr, int item, int lane) {
    const int nblk = N / 32, kb = item / nblk, nb = item % nblk, k0 = 64 * kb, n0 = 32 * nb;
#pragma unroll 8
    for (int i = 0; i < 32; ++i) { const int kk = 2 * i + (lane >> 5); scr[kk * 33 + (lane & 31)] = W[(size_t)(k0 + kk) * N + n0 + (lane & 31)]; }
    LDS_WAIT(); asm volatile("" ::: "memory");
    const int c = lane & 7;
#pragma unroll
    for (int j = 0; j < 4; ++j) { const int n = (lane >> 3) + 8 * j; const LAS float* s = scr + (8 * c) * 33 + n;
        v4u o; o.x = pk2(s[0 * 33], s[1 * 33]); o.y = pk2(s[2 * 33], s[3 * 33]); o.z = pk2(s[4 * 33], s[5 * 33]); o.w = pk2(s[6 * 33], s[7 * 33]);
        *(GAS v4u*)(WT + (size_t)(n0 + n) * K + k0 + 8 * c) = o; }
    LDS_WAIT(); asm volatile("" ::: "memory");
}
__device__ __forceinline__ int rel_bucket_dev(int d) {
    if (d < 16) return d;
    int b = 16;
    b += (d >= 22); b += (d >= 30); b += (d >= 40); b += (d >= 54); b += (d >= 73); b += (d >= 99); b += (d >= 134); b += (d >= 182);
    b += (d >= 246); b += (d >= 332); b += (d >= 450); b += (d >= 609); b += (d >= 825); b += (d >= 1117); b += (d >= 1513);
    return b;
}
__device__ __forceinline__ void p0_prologue(Frame& F, const Args& A) {
    LAS float* scr = (LAS float*)(F.lds + RING_OFF + F.wave * 16384);
    const int gw = F.vcu * NWAVES + F.wave, NGW = F.G * NWAVES;
    bf16* WTin = (bf16*)(A.ws + WS_WTIN); bf16* WTout = (bf16*)(A.ws + WS_WTOUT); bf16* XB = (bf16*)(A.ws + WS_XB);
    constexpr int I_IN = (DM / 64) * (DIN / 32), I_OUT = (DM / 64) * (DM / 32);
    for (int it = gw; it < I_IN + I_OUT; it += NGW) {
        if (it < I_IN) p0_transpose_item(A.in[5], DM, DIN, WTin, scr, it, F.lane);
        else p0_transpose_item(A.in[6], DM, DM, WTout, scr, it - I_IN, F.lane);
    }
    for (int m = gw; m < MT; m += NGW) {
        const float* xrow = (m < MP) ? A.in[0] + (size_t)m * DM : A.in[1] + (size_t)(m - MP) * DM;
        const GAS f32x4* xr = (const GAS f32x4*)xrow + F.lane;
        GAS v2u* o8 = (GAS v2u*)(XB + (size_t)m * DM) + F.lane;
#pragma unroll
        for (int j = 0; j < 4; ++j) { const f32x4 v = xr[64 * j]; v2u w; w.x = pk2(v.x, v.y); w.y = pk2(v.z, v.w); o8[64 * j] = w; }
    }
    { float* bs = (float*)(A.ws + WS_BS);
      for (int i = blockIdx.x * (NWAVES * 64) + F.tid; i < 2049 * 8; i += F.G * NWAVES * 64) bs[i] = A.in[7][rel_bucket_dev(i >> 3) * 8 + (i & 7)] * LOG2E; }
    if (blockIdx.x == 0) {
        float* lbv = (float*)(A.ws + WS_LBV); float* bt = (float*)(A.ws + WS_BIAST);
        const int t = F.tid;
        { const float a0 = A.in[8][t], a1 = A.in[8][512 + t]; lbv[t] = 1.0f / (1.0f + expf(a1 - a0)); }
        for (int i = t; i < 3 * 8 * 132; i += NWAVES * 64) {
            const int j = i % 132, hh = (i / 132) % 8, c = i / (132 * 8);
            const int dil = c == 0 ? 1 : (c == 1 ? 4 : 16);
            bt[i] = (j <= 128) ? A.in[7][rel_bucket_dev(dil * j) * 8 + hh] * LOG2E : 0.f;
        }
    }
}
__device__ __forceinline__ void ln_row_inplace(float* zrow, const float* g, const float* b, int lane) {
    GAS f32x4* zr = (GAS f32x4*)zrow + lane;
    f32x4 v[4]; float s = 0.f;
#pragma unroll
    for (int j = 0; j < 4; ++j) { v[j] = zr[64 * j]; s += (v[j].x + v[j].y) + (v[j].z + v[j].w); }
    const float mean = wave_sum(s) * (1.f / DM); float s2 = 0.f;
#pragma unroll
    for (int j = 0; j < 4; ++j) { v[j] = v[j] - mean; s2 += (v[j].x * v[j].x + v[j].y * v[j].y) + (v[j].z * v[j].z + v[j].w * v[j].w); }
    const float rstd = 1.f / sqrtf(wave_sum(s2) * (1.f / DM) + LN_EPS);
#pragma unroll
    for (int j = 0; j < 4; ++j) { const f32x4 gg = *((const f32x4*)g + lane + 64 * j), bb = *((const f32x4*)b + lane + 64 * j); zr[64 * j] = v[j] * rstd * gg + bb; }
}
namespace attn {
typedef float f32x16 __attribute__((ext_vector_type(16)));
typedef short s16x4 __attribute__((ext_vector_type(4)));
constexpr int KROWS = 384;
constexpr int L_K = 0, L_V = KROWS * 128, L_BIAS = 2 * KROWS * 128, L_END = L_BIAS + 544;
__device__ __forceinline__ int swz(int r) { return (((r >> 1) & 1) << 2) | ((r >> 2) & 3); }
__device__ __forceinline__ int crow(int reg, int hi) { return (reg & 3) + 8 * (reg >> 2) + 4 * hi; }
__device__ __forceinline__ s16x4 tr_read(LAS const unsigned char* p) {
    typedef short v4s __attribute__((ext_vector_type(4)));
    return __builtin_bit_cast(s16x4, __builtin_amdgcn_ds_read_tr16_b64_v4i16((LAS v4s*)p));
}
struct Tensors { const bf16* Q; const bf16* K; const bf16* V; bf16* OP; float* LSE; const float* biasT; };

__device__ __forceinline__ void unit(LAS unsigned char* lds, const Tensors& T, int cfg, int b, int h, int res, int qb, int tid) {
    const int lane = tid & 63, wid = __builtin_amdgcn_readfirstlane(tid >> 6), r32 = lane & 31, hi = lane >> 5;
    const int dil = cfg == 0 ? 1 : (cfg == 1 ? 4 : 16);
    const int P0 = qb * 256;
    const size_t rowb = (size_t)b * SEQ;
    {
        const bf16* Kh = T.K + h * 64; const bf16* Vh = T.V + h * 64;
#pragma unroll
        for (int i = 0; i < 6; ++i) {
            const int e = tid + i * 512;
            const int row = e >> 3, ch = e & 7;
            int pos = P0 - 128 + row; pos = pos < 0 ? 0 : pos;
            const size_t g = (rowb + (size_t)pos * dil + res) * 512 + ch * 8;
            const v4u kv = *(const v4u*)(Kh + g), vv = *(const v4u*)(Vh + g);
            const int off = row * 128 + ((ch ^ swz(row)) << 4);
            *(LAS v4u*)(lds + L_K + off) = kv; *(LAS v4u*)(lds + L_V + off) = vv;
        }
        if (tid < 132) ((LAS float*)(lds + L_BIAS))[tid] = T.biasT[(cfg * 8 + h) * 132 + tid];
    }
    const int qpos = P0 + 32 * wid + r32;
    const size_t qtok = rowb + (size_t)qpos * dil + res;
    bf16x8 qf[4];
#pragma unroll
    for (int d0 = 0; d0 < 4; ++d0) qf[d0] = *(const bf16x8*)(T.Q + qtok * 512 + h * 64 + d0 * 16 + hi * 8);
    __syncthreads();
    float m = -1e30f, l = 0.f;
    f32x16 o0 = {}, o1 = {};
    const LAS float* bias = (const LAS float*)(lds + L_BIAS);
#pragma unroll 1
    for (int kt = 0; kt < 5; ++kt) {
        const int krow0 = 32 * (wid + kt);
        f32x16 s = {};
        {
            const int row = krow0 + r32; const int sw = swz(row);
            const LAS unsigned char* kb = lds + L_K + row * 128;
#pragma unroll
            for (int d0 = 0; d0 < 4; ++d0) {
                const bf16x8 kf = *(const LAS bf16x8*)(kb + (((2 * d0 + hi) ^ sw) << 4));
                s = __builtin_amdgcn_mfma_f32_32x32x16_bf16(kf, qf[d0], s, 0, 0, 0);
            }
        }
        float mx = -1e30f;
#pragma unroll
        for (int r = 0; r < 16; ++r) {
            const int kr = crow(r, hi);
            const int delta = 128 + r32 - 32 * kt - kr;
            const bool ok = (delta >= 0) && (delta <= 128) && (P0 - 128 + krow0 + kr >= 0);
            const int dc = delta < 0 ? 0 : (delta > 128 ? 128 : delta);
            const float v = s[r] * LOG2E + bias[dc];
            s[r] = ok ? v : -1e30f;
            mx = fmaxf(mx, s[r]);
        }
        mx = fmaxf(mx, __shfl_xor(mx, 32));
        const float mn = fmaxf(m, mx);
        const float corr = __builtin_amdgcn_exp2f(m - mn);
        m = mn;
        float ps = 0.f;
#pragma unroll
        for (int r = 0; r < 16; ++r) { s[r] = __builtin_amdgcn_exp2f(s[r] - mn); ps += s[r]; }
        l = l * corr + ps;
#pragma unroll
        for (int r = 0; r < 16; ++r) { o0[r] *= corr; o1[r] *= corr; }
        bf16x8 pf[2];
#pragma unroll
        for (int ks = 0; ks < 2; ++ks) {
            v4u w; w.x = pk2(s[8 * ks + 0], s[8 * ks + 1]); w.y = pk2(s[8 * ks + 2], s[8 * ks + 3]); w.z = pk2(s[8 * ks + 4], s[8 * ks + 5]); w.w = pk2(s[8 * ks + 6], s[8 * ks + 7]);
            pf[ks] = __builtin_bit_cast(bf16x8, w);
        }
#pragma unroll
        for (int ks = 0; ks < 2; ++ks) {
#pragma unroll
            for (int db = 0; db < 2; ++db) {
                s16x4 lo, hh;
                {
                    const int c = 4 * db + 2 * ((lane >> 4) & 1) + ((lane & 3) >> 1);
                    const int krA = krow0 + 16 * ks + 4 * hi + ((lane & 15) >> 2);
                    const int krB = krA + 8;
                    lo = tr_read(lds + L_V + krA * 128 + ((c ^ swz(krA)) << 4) + 8 * (lane & 1));
                    hh = tr_read(lds + L_V + krB * 128 + ((c ^ swz(krB)) << 4) + 8 * (lane & 1));
                }
                const bf16x8 vf = (bf16x8){lo[0], lo[1], lo[2], lo[3], hh[0], hh[1], hh[2], hh[3]};
                if (db == 0) o0 = __builtin_amdgcn_mfma_f32_32x32x16_bf16(vf, pf[ks], o0, 0, 0, 0);
                else o1 = __builtin_amdgcn_mfma_f32_32x32x16_bf16(vf, pf[ks], o1, 0, 0, 0);
            }
        }
    }
    const float lt = l + __shfl_xor(l, 32);
    const float inv = 1.0f / lt;
    bf16* op = T.OP + ((size_t)cfg * MP + qtok) * 512 + h * 64;
#pragma unroll
    for (int g = 0; g < 4; ++g) {
        v2u w0, w1;
        w0.x = pk2(o0[4 * g] * inv, o0[4 * g + 1] * inv); w0.y = pk2(o0[4 * g + 2] * inv, o0[4 * g + 3] * inv);
        w1.x = pk2(o1[4 * g] * inv, o1[4 * g + 1] * inv); w1.y = pk2(o1[4 * g + 2] * inv, o1[4 * g + 3] * inv);
        *(v2u*)(op + 8 * g + 4 * hi) = w0;
        *(v2u*)(op + 32 + 8 * g + 4 * hi) = w1;
    }
    if (hi == 0) T.LSE[((size_t)cfg * MP + qtok) * 8 + h] = m + __builtin_amdgcn_logf(lt);
    __syncthreads();
}
__device__ __forceinline__ void phase(LAS unsigned char* lds, const Tensors& T, int vcu, int G, int tid) {
    constexpr int NUNITS = 3 * NB * 8 * 32;
    for (int u = vcu; u < NUNITS; u += G) {
        const int j = u & 31, h = (u >> 5) & 7, b = (u >> 8) & 3, cfg = u >> 10;
        const int dil = cfg == 0 ? 1 : (cfg == 1 ? 4 : 16);
        const int nblk = 32 / dil;
        const int res = j / nblk, qb = j % nblk;
        unit(lds, T, cfg, b, h, res, qb, tid);
    }
}
__device__ __forceinline__ void combine(const Tensors& T, const bf16* GA, bf16* MIX, int gtid, int gthreads) {
    for (int i = gtid; i < MP * 64; i += gthreads) {
        const int tok = i >> 6, ch = i & 63, h = ch >> 3;
        const float l0 = T.LSE[((size_t)0 * MP + tok) * 8 + h], l1 = T.LSE[((size_t)1 * MP + tok) * 8 + h], l2 = T.LSE[((size_t)2 * MP + tok) * 8 + h];
        const float mx = fmaxf(l0, fmaxf(l1, l2));
        float w0 = __builtin_amdgcn_exp2f(l0 - mx), w1 = __builtin_amdgcn_exp2f(l1 - mx), w2 = __builtin_amdgcn_exp2f(l2 - mx);
        const float inv = 1.0f / (w0 + w1 + w2); w0 *= inv; w1 *= inv; w2 *= inv;
        const v4u a0 = *(const v4u*)(T.OP + ((size_t)0 * MP + tok) * 512 + ch * 8), a1 = *(const v4u*)(T.OP + ((size_t)1 * MP + tok) * 512 + ch * 8), a2 = *(const v4u*)(T.OP + ((size_t)2 * MP + tok) * 512 + ch * 8);
        const v4u gg = *(const v4u*)(GA + (size_t)tok * 512 + ch * 8);
        v4u o;
#pragma unroll
        for (int k = 0; k < 4; ++k) {
            const float lo = (w0 * bf2f((unsigned short)(a0[k] & 0xffff)) + w1 * bf2f((unsigned short)(a1[k] & 0xffff)) + w2 * bf2f((unsigned short)(a2[k] & 0xffff))) * bf2f((unsigned short)(gg[k] & 0xffff));
            const float hi_ = (w0 * bf2f((unsigned short)(a0[k] >> 16)) + w1 * bf2f((unsigned short)(a1[k] >> 16)) + w2 * bf2f((unsigned short)(a2[k] >> 16))) * bf2f((unsigned short)(gg[k] >> 16));
            o[k] = pk2(lo, hi_);
        }
        *(v4u*)(MIX + (size_t)tok * 1024 + ch * 8) = o;
    }
}
}
namespace hg {
typedef float f32x16 __attribute__((ext_vector_type(16)));
typedef short s16x4 __attribute__((ext_vector_type(4)));
typedef float f32x2 __attribute__((ext_vector_type(2)));
constexpr int SC = 512, NSC = SEQ / SC, NSUB = SC / 64;
constexpr int L_QT = 0, L_QH = 16384, L_KT = 32768, L_KH = 49152, L_V = 65536, L_TOT = 81920, L_EBC = 86016, L_OUT = 86528, L_END = L_OUT + 64 * 132 * 4;
static_assert(L_END <= RING_BYTES, "hgrn LDS");
__device__ __forceinline__ int a_row(int row, int c) { return row * 256 + ((c ^ (row & 15)) << 4); }
__device__ __forceinline__ int a_qt(int row, int gq) { return row * 256 + ((gq ^ (row & 31)) << 3); }
__device__ __forceinline__ int a_tr(int row, int c) { return row * 256 + ((c ^ ((row & 3) << 2)) << 4); }
__device__ __forceinline__ int crow(int reg, int hi) { return (reg & 3) + 8 * (reg >> 2) + 4 * hi; }
__device__ __forceinline__ s16x4 tr_read(LAS const unsigned char* p) {
    typedef short v4s __attribute__((ext_vector_type(4)));
    return __builtin_bit_cast(s16x4, __builtin_amdgcn_ds_read_tr16_b64_v4i16((LAS v4s*)p));
}
__device__ __forceinline__ bf16x8 pack8(const f32x16& x, int base) {
    v4u w; w.x = pk2(x[base + 0], x[base + 1]); w.y = pk2(x[base + 2], x[base + 3]); w.z = pk2(x[base + 4], x[base + 5]); w.w = pk2(x[base + 6], x[base + 7]);
    return __builtin_bit_cast(bf16x8, w);
}
struct Tensors { const float* GF; const bf16* QB; const bf16* VB; const bf16* GB; const float* norm_g; bf16* MIX; float* PL; float* PD; float* PS; };

template <int MODE>
__device__ __forceinline__ void unit(LAS unsigned char* lds, const Tensors& T, int b, int hh, int sc, int tid) {
    const int lane = tid & 63, wid = __builtin_amdgcn_readfirstlane(tid >> 6), r32 = lane & 31, hi = lane >> 5;
    const int vt = wid & 3, th = wid >> 2;
    const int uidx = (b * 4 + hh) * NSC + sc;
    const size_t row_base = (size_t)b * SEQ + (size_t)sc * SC;
    f32x16 S[4];
#pragma unroll
    for (int kt = 0; kt < 4; ++kt) {
        if (MODE == 1 && sc > 0) {
            const float* hs = T.PS + (size_t)uidx * 16384;
#pragma unroll
            for (int r = 0; r < 16; ++r) S[kt][r] = hs[(32 * kt + crow(r, hi)) * 128 + 32 * vt + r32];
        } else {
#pragma unroll
            for (int r = 0; r < 16; ++r) S[kt][r] = 0.f;
        }
    }
    const int kp = tid & 63, seg = wid;
    float dlog0 = 0.f, dlog1 = 0.f;
    LAS float* TOT = (LAS float*)(lds + L_TOT);
    LAS float* EBC = (LAS float*)(lds + L_EBC);
    LAS float* OUT = (LAS float*)(lds + L_OUT);
#pragma unroll 1
    for (int sub = 0; sub < NSUB; ++sub) {
        const size_t row0 = row_base + (size_t)sub * 64;
        float bl0[8], bl1[8], g0[8], g1[8]; unsigned qraw[8];
        {
            const float* gp = T.GF + (row0 + 8 * seg) * 512 + hh * 128 + 2 * kp;
            const bf16* qp = T.QB + (row0 + 8 * seg) * 512 + hh * 128 + 2 * kp;
#pragma unroll
            for (int i = 0; i < 8; ++i) { const f32x2 gg = *(const f32x2*)(gp + (size_t)i * 512); g0[i] = gg.x; g1[i] = gg.y; if (MODE == 1) qraw[i] = *(const unsigned*)(qp + (size_t)i * 512); }
            float a0 = 0.f, a1 = 0.f;
#pragma unroll
            for (int i = 0; i < 8; ++i) { a0 += g0[i]; a1 += g1[i]; bl0[i] = a0; bl1[i] = a1; }
            TOT[seg * 128 + 2 * kp] = a0; TOT[seg * 128 + 2 * kp + 1] = a1;
#pragma unroll
            for (int i = 0; i < 2; ++i) {
                const int e = tid + i * 512, row = e >> 4, ch = e & 15;
                const v4u vv = *(const v4u*)(T.VB + (row0 + row) * 512 + hh * 128 + ch * 8);
                *(LAS v4u*)(lds + L_V + a_tr(row, ch)) = vv;
            }
        }
        __syncthreads();
        {
            float off0 = 0.f, off1 = 0.f, bc0 = 0.f, bc1 = 0.f, rr0 = 0.f, rr1 = 0.f;
#pragma unroll
            for (int s = 0; s < 8; ++s) {
                const float t0 = TOT[s * 128 + 2 * kp], t1 = TOT[s * 128 + 2 * kp + 1];
                if (s < seg) { off0 += t0; off1 += t1; }
                if (s < 4) { rr0 += t0; rr1 += t1; }
                bc0 += t0; bc1 += t1;
            }
            if (seg == 0) { EBC[2 * kp] = __expf(bc0); EBC[2 * kp + 1] = __expf(bc1); dlog0 += bc0; dlog1 += bc1; }
            const float c1a = __expf(-rr0), c1b = __expf(-rr1), c2a = __expf(rr0 - bc0), c2b = __expf(rr1 - bc1);
#pragma unroll
            for (int i = 0; i < 8; ++i) {
                const int row = 8 * seg + i;
                const float b0 = off0 + bl0[i], b1 = off1 + bl1[i];
                const float kk0 = 1.0f - __expf(g0[i]), kk1 = 1.0f - __expf(g1[i]);
                const float kt0 = kk0 * __expf(bc0 - b0), kt1 = kk1 * __expf(bc1 - b1);
                *(LAS unsigned*)(lds + L_KT + a_tr(row, kp >> 2) + (kp & 3) * 4) = pk2(kt0, kt1);
                if (MODE == 1) {
                    const float q0 = bf2f((unsigned short)(qraw[i] & 0xffff)), q1 = bf2f((unsigned short)(qraw[i] >> 16));
                    const float qt0 = q0 * __expf(b0), qt1 = q1 * __expf(b1);
                    *(LAS unsigned*)(lds + L_QT + a_qt(row, kp >> 1) + (kp & 1) * 4) = pk2(qt0, qt1);
                    *(LAS unsigned*)(lds + L_QH + a_row(row, kp >> 2) + (kp & 3) * 4) = pk2(qt0 * c1a, qt1 * c1b);
                    *(LAS unsigned*)(lds + L_KH + a_row(row, kp >> 2) + (kp & 3) * 4) = pk2(kt0 * c2a, kt1 * c2b);
                }
            }
        }
        __syncthreads();
        if (MODE == 1) {
            bf16x8 pX[2][2];
#pragma unroll
            for (int st = 0; st < 2; ++st) {
                if (st <= th) {
                    f32x16 X = {};
#pragma unroll
                    for (int k8 = 0; k8 < 8; ++k8) {
                        const bf16x8 af = *(const LAS bf16x8*)(lds + L_KH + a_row(32 * st + r32, 2 * k8 + hi));
                        const bf16x8 bfr = *(const LAS bf16x8*)(lds + L_QH + a_row(32 * th + r32, 2 * k8 + hi));
                        X = __builtin_amdgcn_mfma_f32_32x32x16_bf16(af, bfr, X, 0, 0, 0);
                    }
                    if (st == th) {
#pragma unroll
                        for (int r = 0; r < 16; ++r) X[r] = (crow(r, hi) <= r32) ? X[r] : 0.f;
                    }
                    pX[st][0] = pack8(X, 0); pX[st][1] = pack8(X, 8);
                } else { pX[st][0] = (bf16x8){0, 0, 0, 0, 0, 0, 0, 0}; pX[st][1] = pX[st][0]; }
            }
            f32x16 o = {};
#pragma unroll
            for (int kt = 0; kt < 4; ++kt)
#pragma unroll
                for (int s = 0; s < 2; ++s) {
                    const int row = 32 * th + r32, gq = 8 * kt + 4 * s + hi;
                    const v2u lo = *(const LAS v2u*)(lds + L_QT + a_qt(row, gq)), hh2 = *(const LAS v2u*)(lds + L_QT + a_qt(row, gq + 2));
                    const v4u aw = {lo.x, lo.y, hh2.x, hh2.y};
                    o = __builtin_amdgcn_mfma_f32_32x32x16_bf16(__builtin_bit_cast(bf16x8, aw), pack8(S[kt], 8 * s), o, 0, 0, 0);
                }
#pragma unroll
            for (int st = 0; st < 2; ++st) {
                if (st <= th) {
#pragma unroll
                    for (int ks = 0; ks < 2; ++ks) {
                        const int c = 4 * vt + 2 * ((lane >> 4) & 1) + ((lane & 3) >> 1);
                        const int rA = 32 * st + 16 * ks + 4 * hi + ((lane & 15) >> 2);
                        const s16x4 lo = tr_read(lds + L_V + a_tr(rA, c) + 8 * (lane & 1)), h2 = tr_read(lds + L_V + a_tr(rA + 8, c) + 8 * (lane & 1));
                        const bf16x8 vf = (bf16x8){lo[0], lo[1], lo[2], lo[3], h2[0], h2[1], h2[2], h2[3]};
                        o = __builtin_amdgcn_mfma_f32_32x32x16_bf16(pX[st][ks], vf, o, 0, 0, 0);
                    }
                }
            }
#pragma unroll
            for (int r = 0; r < 16; ++r) OUT[(32 * th + crow(r, hi)) * 132 + 32 * vt + r32] = o[r];
        }
#pragma unroll
        for (int kt = 0; kt < 4; ++kt) {
#pragma unroll
            for (int r = 0; r < 16; ++r) S[kt][r] *= EBC[32 * kt + crow(r, hi)];
#pragma unroll
            for (int ts = 0; ts < 4; ++ts) {
                const int rA = 16 * ts + 8 * hi + ((lane & 15) >> 2);
                const int ck = 4 * kt + 2 * ((lane >> 4) & 1) + ((lane & 3) >> 1), cv = 4 * vt + 2 * ((lane >> 4) & 1) + ((lane & 3) >> 1);
                const s16x4 ka = tr_read(lds + L_KT + a_tr(rA, ck) + 8 * (lane & 1)), kb = tr_read(lds + L_KT + a_tr(rA + 4, ck) + 8 * (lane & 1));
                const s16x4 va = tr_read(lds + L_V + a_tr(rA, cv) + 8 * (lane & 1)), vb = tr_read(lds + L_V + a_tr(rA + 4, cv) + 8 * (lane & 1));
                const bf16x8 kf = (bf16x8){ka[0], ka[1], ka[2], ka[3], kb[0], kb[1], kb[2], kb[3]};
                const bf16x8 vf = (bf16x8){va[0], va[1], va[2], va[3], vb[0], vb[1], vb[2], vb[3]};
                S[kt] = __builtin_amdgcn_mfma_f32_32x32x16_bf16(kf, vf, S[kt], 0, 0, 0);
            }
        }
        __syncthreads();
        if (MODE == 1) {
            const int t = tid >> 3, vs = tid & 7;
            float x[16]; float ss = 0.f;
#pragma unroll
            for (int i = 0; i < 16; ++i) { x[i] = OUT[t * 132 + 16 * vs + i]; ss += x[i] * x[i]; }
            ss += __shfl_xor(ss, 1); ss += __shfl_xor(ss, 2); ss += __shfl_xor(ss, 4);
            const float rs = 1.0f / sqrtf(ss * (1.0f / 128.0f) + 1e-5f);
            const size_t grow = row0 + t;
            const v4u gb0 = *(const v4u*)(T.GB + grow * 512 + hh * 128 + 16 * vs), gb1 = *(const v4u*)(T.GB + grow * 512 + hh * 128 + 16 * vs + 8);
            v4u o0, o1;
#pragma unroll
            for (int k = 0; k < 4; ++k) {
                const float n0 = T.norm_g[16 * vs + 2 * k], n1 = T.norm_g[16 * vs + 2 * k + 1], n2 = T.norm_g[16 * vs + 8 + 2 * k], n3 = T.norm_g[16 * vs + 8 + 2 * k + 1];
                o0[k] = pk2(x[2 * k] * rs * n0 * bf2f((unsigned short)(gb0[k] & 0xffff)), x[2 * k + 1] * rs * n1 * bf2f((unsigned short)(gb0[k] >> 16)));
                o1[k] = pk2(x[8 + 2 * k] * rs * n2 * bf2f((unsigned short)(gb1[k] & 0xffff)), x[8 + 2 * k + 1] * rs * n3 * bf2f((unsigned short)(gb1[k] >> 16)));
            }
            bf16* mp = T.MIX + grow * 1024 + 512 + hh * 128 + 16 * vs;
            *(v4u*)mp = o0; *(v4u*)(mp + 8) = o1;
        }
    }
    if (MODE == 0) {
        if (th == 0) {
            float* hl = T.PL + (size_t)uidx * 16384;
#pragma unroll
            for (int kt = 0; kt < 4; ++kt)
#pragma unroll
                for (int r = 0; r < 16; ++r) hl[(32 * kt + crow(r, hi)) * 128 + 32 * vt + r32] = S[kt][r];
        }
        if (seg == 0) { T.PD[(size_t)uidx * 128 + 2 * kp] = dlog0; T.PD[(size_t)uidx * 128 + 2 * kp + 1] = dlog1; }
    }
}
template <int MODE>
__device__ __forceinline__ void phase(LAS unsigned char* lds, const Tensors& T, int vcu, int G, int tid) {
    for (int u = vcu; u < NB * 4 * NSC; u += G) { const int sc = u % NSC, hh = (u / NSC) & 3, b = u / (NSC * 4); unit<MODE>(lds, T, b, hh, sc, tid); }
}
__device__ __forceinline__ void carry(const Tensors& T, float* sp, int gtid, int gthreads) {
    for (int i = gtid; i < NB * 4 * 16384; i += gthreads) {
        const int bh = i >> 14, e = i & 16383, k = e >> 7;
        float S = 0.f;
#pragma unroll 1
        for (int sc = 0; sc < NSC; ++sc) {
            const size_t u = (size_t)bh * NSC + sc;
            S = __expf(T.PD[u * 128 + k]) * S + T.PL[u * 16384 + e];
            if (sc + 1 < NSC) T.PS[(u + 1) * 16384 + e] = S; else sp[(size_t)bh * 16384 + e] = S;
        }
    }
}
__device__ __forceinline__ void sample_unit(LAS unsigned char* lds, const Tensors& T, const float* S0, float* Sout, int b, int hh, int tid) {
    LAS float* FK = (LAS float*)lds;
    LAS float* QQ = FK + 1024;
    LAS float* PART = QQ + 1024;
    LAS float* RS = PART + 4096;
    const size_t row0 = (size_t)MP + (size_t)b * 8;
    for (int i = tid; i < 1024; i += 512) { const int t = i >> 7, k = i & 127; FK[i] = __expf(T.GF[(row0 + t) * 512 + hh * 128 + k]); QQ[i] = bf2f(T.QB[(row0 + t) * 512 + hh * 128 + k]); }
    const int v = tid & 127, kq = tid >> 7;
    float S[32];
    const float* s0 = S0 + ((size_t)(b * 4 + hh) * 128 + 32 * kq) * 128 + v;
#pragma unroll
    for (int i = 0; i < 32; ++i) S[i] = s0[(size_t)i * 128];
    __syncthreads();
#pragma unroll 1
    for (int t = 0; t < 8; ++t) {
        const float iv = bf2f(T.VB[(row0 + t) * 512 + hh * 128 + v]);
        float po = 0.f;
#pragma unroll
        for (int i = 0; i < 32; ++i) { const float f = FK[t * 128 + 32 * kq + i]; S[i] = f * S[i] + (1.0f - f) * iv; po += S[i] * QQ[t * 128 + 32 * kq + i]; }
        PART[(kq * 8 + t) * 128 + v] = po;
    }
    float* so = Sout + ((size_t)(b * 4 + hh) * 128 + 32 * kq) * 128 + v;
#pragma unroll
    for (int i = 0; i < 32; ++i) so[(size_t)i * 128] = S[i];
    __syncthreads();
    {
        const int t = tid >> 6, l = tid & 63;
        const float a = PART[(0 * 8 + t) * 128 + l] + PART[(1 * 8 + t) * 128 + l] + PART[(2 * 8 + t) * 128 + l] + PART[(3 * 8 + t) * 128 + l];
        const float c = PART[(0 * 8 + t) * 128 + 64 + l] + PART[(1 * 8 + t) * 128 + 64 + l] + PART[(2 * 8 + t) * 128 + 64 + l] + PART[(3 * 8 + t) * 128 + 64 + l];
        float ss = a * a + c * c;
#pragma unroll
        for (int o = 1; o < 64; o <<= 1) ss += __shfl_xor(ss, o);
        const float rs = 1.0f / sqrtf(ss * (1.0f / 128.0f) + 1e-5f);
        const size_t grow = row0 + t;
        const float ga = bf2f(T.GB[grow * 512 + hh * 128 + l]), gc = bf2f(T.GB[grow * 512 + hh * 128 + 64 + l]);
        T.MIX[grow * 1024 + 512 + hh * 128 + l] = (bf16)f2bf(a * rs * T.norm_g[l] * ga);
        T.MIX[grow * 1024 + 512 + hh * 128 + 64 + l] = (bf16)f2bf(c * rs * T.norm_g[64 + l] * gc);
    }
    __syncthreads();
}
__device__ __forceinline__ void sample_phase(LAS unsigned char* lds, const Tensors& T, const float* S0, float* Sout, int vcu, int G, int tid) {
    for (int u = vcu; u < DB * 4; u += G) sample_unit(lds, T, S0, Sout, u >> 2, u & 3, tid);
}
}
namespace sa {
constexpr int NPART = 32;
constexpr int PROW = 68;
constexpr int PSTRIDE = 8 * 8 * PROW;
struct Tensors { const float* ck; const float* cv; const bf16* QA; const bf16* KA; const bf16* VA; const float* bs; float* part; };

__device__ __forceinline__ void load_new_row(const Tensors& T, int b, int e, int lane, float (&k)[8], float (&v)[8]) {
    const size_t row = (size_t)MP + (size_t)b * 8 + (e - WIN); const int c = (lane >> 3) * 64 + (lane & 7) * 4;
    const v2u ka = *(const v2u*)(T.KA + row * 512 + c), kb = *(const v2u*)(T.KA + row * 512 + c + 32), va = *(const v2u*)(T.VA + row * 512 + c), vb = *(const v2u*)(T.VA + row * 512 + c + 32);
    k[0] = bf2f((unsigned short)(ka.x & 0xffff)); k[1] = bf2f((unsigned short)(ka.x >> 16)); k[2] = bf2f((unsigned short)(ka.y & 0xffff)); k[3] = bf2f((unsigned short)(ka.y >> 16));
    k[4] = bf2f((unsigned short)(kb.x & 0xffff)); k[5] = bf2f((unsigned short)(kb.x >> 16)); k[6] = bf2f((unsigned short)(kb.y & 0xffff)); k[7] = bf2f((unsigned short)(kb.y >> 16));
    v[0] = bf2f((unsigned short)(va.x & 0xffff)); v[1] = bf2f((unsigned short)(va.x >> 16)); v[2] = bf2f((unsigned short)(va.y & 0xffff)); v[3] = bf2f((unsigned short)(va.y >> 16));
    v[4] = bf2f((unsigned short)(vb.x & 0xffff)); v[5] = bf2f((unsigned short)(vb.x >> 16)); v[6] = bf2f((unsigned short)(vb.y & 0xffff)); v[7] = bf2f((unsigned short)(vb.y >> 16));
}
struct RowBuf { float k0[8], v0[8], k1[8], v1[8]; };
__device__ __forceinline__ void score_row(const LAS float* bsL, int e, int hh, const float (&k)[8], const float (&v)[8], const v4u (&q)[8], float (&acc)[8][8], float (&m)[8], float (&l)[8]) {
#pragma unroll
    for (int t = 0; t < 8; ++t) {
        const int delta = WIN + t - e;
        if (delta < 0) continue;
        const int mult = (delta <= 128 ? 1 : 0) + (((delta & 3) == 0 && delta <= 512) ? 1 : 0) + (((delta & 15) == 0) ? 1 : 0);
        if (mult == 0) continue;
        float d = 0.f;
        v4u qt = q[t]; asm volatile("" : "+v"(qt));
#pragma unroll
        for (int i = 0; i < 4; ++i) d += __builtin_bit_cast(float, qt[i] << 16) * k[2 * i] + __builtin_bit_cast(float, qt[i] & 0xffff0000u) * k[2 * i + 1];
        d += __shfl_xor(d, 1); d += __shfl_xor(d, 2); d += __shfl_xor(d, 4);
        const float s = d * LOG2E + bsL[delta * 8 + hh];
        const float mn = fmaxf(m[t], s);
        const float corr = __builtin_amdgcn_exp2f(m[t] - mn), p = (float)mult * __builtin_amdgcn_exp2f(s - mn);
        l[t] = l[t] * corr + p;
#pragma unroll
        for (int i = 0; i < 8; ++i) acc[t][i] = acc[t][i] * corr + p * v[i];
        m[t] = mn;
    }
}
__device__ __forceinline__ void load_cache_row(const Tensors& T, int b, int e, int lane, float (&k)[8], float (&v)[8]) {
    const int c = (lane >> 3) * 64 + (lane & 7) * 4;
    const float* kp = T.ck + ((size_t)b * WIN + e) * 512 + c; const float* vp = T.cv + ((size_t)b * WIN + e) * 512 + c;
    const f32x4 k0 = __builtin_nontemporal_load((const f32x4*)kp), k1 = __builtin_nontemporal_load((const f32x4*)(kp + 32));
    const f32x4 v0 = __builtin_nontemporal_load((const f32x4*)vp), v1 = __builtin_nontemporal_load((const f32x4*)(vp + 32));
#pragma unroll
    for (int i = 0; i < 4; ++i) { k[i] = k0[i]; k[4 + i] = k1[i]; v[i] = v0[i]; v[4 + i] = v1[i]; }
}
__device__ __forceinline__ void store_row(float* kws, float* vws, float* dummy, int b, int e, int lane, const float (&k)[8], const float (&v)[8]) {
    const int c = (lane >> 3) * 64 + (lane & 7) * 4;
    float* kd = (e >= 8 ? kws + ((size_t)b * WIN + (e - 8)) * 512 : dummy) + c; float* vd = (e >= 8 ? vws + ((size_t)b * WIN + (e - 8)) * 512 : dummy + 512) + c;
    __builtin_nontemporal_store((f32x4){k[0], k[1], k[2], k[3]}, (f32x4*)kd); __builtin_nontemporal_store((f32x4){k[4], k[5], k[6], k[7]}, (f32x4*)(kd + 32));
    __builtin_nontemporal_store((f32x4){v[0], v[1], v[2], v[3]}, (f32x4*)vd); __builtin_nontemporal_store((f32x4){v[4], v[5], v[6], v[7]}, (f32x4*)(vd + 32));
}
__device__ __forceinline__ void fused_unit(const LAS float* bsL, const Tensors& T, float* kws, float* vws, float* dummy, int b, int j4, int tid) {
    const int lane = tid & 63, wid = __builtin_amdgcn_readfirstlane(tid >> 6), hh = lane >> 3;
    v4u q[8]; float acc[8][8], m[8], l[8];
#pragma unroll
    for (int t = 0; t < 8; ++t) {
        { const bf16* qp = T.QA + ((size_t)MP + (size_t)b * 8 + t) * 512 + (lane >> 3) * 64 + (lane & 7) * 4; const v2u qa = *(const v2u*)qp, qb = *(const v2u*)(qp + 32); q[t] = (v4u){qa.x, qa.y, qb.x, qb.y}; }
#pragma unroll
        for (int i = 0; i < 8; ++i) acc[t][i] = 0.f;
        m[t] = -1e30f; l[t] = 0.f;
    }
    const int ebase = 8 * j4 + wid;
    RowBuf A, B;
    const int rot = (b * 5) & 63;
#define SA_ROW(i) (ebase + 32 * (((i) + rot) & 63))
    load_cache_row(T, b, SA_ROW(0), lane, A.k0, A.v0); load_cache_row(T, b, SA_ROW(1), lane, A.k1, A.v1);
#pragma unroll 1
    for (int jt = 0; jt < 16; ++jt) {
        const int i0 = 4 * jt;
        const int eA0 = SA_ROW(i0), eA1 = SA_ROW(i0 + 1), eB0 = SA_ROW(i0 + 2), eB1 = SA_ROW(i0 + 3);
        const int eN0 = SA_ROW(i0 + 4), eN1 = SA_ROW(i0 + 5);
        load_cache_row(T, b, eB0, lane, B.k0, B.v0); load_cache_row(T, b, eB1, lane, B.k1, B.v1);
        store_row(kws, vws, dummy, b, eA0, lane, A.k0, A.v0); store_row(kws, vws, dummy, b, eA1, lane, A.k1, A.v1);
        score_row(bsL, eA0, hh, A.k0, A.v0, q, acc, m, l); score_row(bsL, eA1, hh, A.k1, A.v1, q, acc, m, l);
        load_cache_row(T, b, eN0, lane, A.k0, A.v0); load_cache_row(T, b, eN1, lane, A.k1, A.v1);
        store_row(kws, vws, dummy, b, eB0, lane, B.k0, B.v0); store_row(kws, vws, dummy, b, eB1, lane, B.k1, B.v1);
        score_row(bsL, eB0, hh, B.k0, B.v0, q, acc, m, l); score_row(bsL, eB1, hh, B.k1, B.v1, q, acc, m, l);
    }
#undef SA_ROW
    if (j4 == 0) {
        load_new_row(T, b, WIN + wid, lane, B.k0, B.v0);
        score_row(bsL, WIN + wid, hh, B.k0, B.v0, q, acc, m, l);
    }
    float* pp = T.part + ((size_t)b * NPART + j4 * 8 + wid) * PSTRIDE;
#pragma unroll
    for (int t = 0; t < 8; ++t) {
        float* o = pp + (t * 8 + hh) * PROW;
        *(f32x4*)(o + 4 * (lane & 7)) = (f32x4){acc[t][0], acc[t][1], acc[t][2], acc[t][3]};
        *(f32x4*)(o + 32 + 4 * (lane & 7)) = (f32x4){acc[t][4], acc[t][5], acc[t][6], acc[t][7]};
        if ((lane & 7) == 0) { o[64] = m[t]; o[65] = l[t]; }
    }
}
__device__ __forceinline__ void fused_phase(LAS unsigned char* lds, const Tensors& T, float* kws, float* vws, float* dummy, int vcu, int G, int tid) {
    LAS float* bsL = (LAS float*)lds;
    for (int i = tid; i < 2049 * 2; i += 512) *((LAS f32x4*)bsL + i) = *((const f32x4*)T.bs + i);
    __syncthreads();
    for (int u = vcu; u < DB * 4; u += G) fused_unit(bsL, T, kws, vws, dummy + (size_t)(vcu * 8 + (tid >> 6)) * 1024, u >> 2, u & 3, tid);
    __syncthreads();
}
__device__ __forceinline__ void combine(const Tensors& T, const bf16* GA, bf16* MIX, int gtid, int gthreads) {
    for (int i = gtid; i < DB * 8 * 8 * 8; i += gthreads) {
        const int c8 = i & 7, h = (i >> 3) & 7, t = (i >> 6) & 7, b = i >> 9;
        const float* p0 = T.part + (size_t)b * NPART * PSTRIDE + (t * 8 + h) * PROW;
        float M = -1e30f;
#pragma unroll
        for (int p = 0; p < NPART; ++p) M = fmaxf(M, p0[(size_t)p * PSTRIDE + 64]);
        float L = 0.f; float o[8];
#pragma unroll
        for (int k = 0; k < 8; ++k) o[k] = 0.f;
#pragma unroll
        for (int p = 0; p < NPART; ++p) {
            const float* pp = p0 + (size_t)p * PSTRIDE;
            const float w = __builtin_amdgcn_exp2f(pp[64] - M);
            L += w * pp[65];
            const f32x4 a0 = *(const f32x4*)(pp + 8 * c8), a1 = *(const f32x4*)(pp + 8 * c8 + 4);
#pragma unroll
            for (int k = 0; k < 4; ++k) { o[k] += w * a0[k]; o[4 + k] += w * a1[k]; }
        }
        const float inv = 1.0f / L;
        const size_t row = (size_t)MP + (size_t)b * 8 + t;
        const v4u gg = *(const v4u*)(GA + row * 512 + h * 64 + 8 * c8);
        v4u w;
#pragma unroll
        for (int k = 0; k < 4; ++k) w[k] = pk2(o[2 * k] * inv * bf2f((unsigned short)(gg[k] & 0xffff)), o[2 * k + 1] * inv * bf2f((unsigned short)(gg[k] >> 16)));
        *(v4u*)(MIX + row * 1024 + h * 64 + 8 * c8) = w;
    }
}
}
#ifndef MK_N_LAUNCHES
#define MK_N_LAUNCHES 1
#endif
constexpr int NPH = 7;
#ifndef MK_REP_SATTN
#define MK_REP_SATTN 1
#endif
#ifndef MK_REP_H
#define MK_REP_H 1
#endif
#ifndef MK_REP_ATTN
#define MK_REP_ATTN 1
#endif
#ifndef MK_BG_COPY
#define MK_BG_COPY 0
#endif
#ifndef MK_BG_COPY5
#define MK_BG_COPY5 0
#endif
#ifndef MK_REP_COPY
#define MK_REP_COPY 1
#endif
__global__ void __launch_bounds__(NWAVES * 64, 2) mk(Args args) {
    extern __shared__ __attribute__((aligned(16))) unsigned char lds[];
    Frame F;
    F.lds = (LAS unsigned char*)lds;
    F.MISC = (volatile LAS unsigned*)(F.lds + MISC_OFF);
    F.tid = threadIdx.x; F.lane = F.tid & 63; F.wave = __builtin_amdgcn_readfirstlane(F.tid >> 6);
    F.G = gridDim.x; { const int bx = blockIdx.x; F.vcu = (F.G % 8 == 0) ? (bx % 8) * (F.G / 8) + bx / 8 : bx; }
    unsigned char* ws = args.ws;
    F.ctl = (gu32*)(ws + WS_CTL);
    for (int u = F.tid; u < (LDS_BYTES - LDSCTL_OFF) / 4; u += NWAVES * 64) ((LAS unsigned*)(F.lds + LDSCTL_OFF))[u] = 0u;
    __syncthreads();
    XcdBarrier bar = xcd_barrier_post((unsigned*)(F.ctl + CW_BAR), F.MISC + 8);
    const int lo = args.ph_lo, hi = args.ph_hi;
#define IN(k) (lo <= (k) && (k) < hi)
#define BOTH(k) (IN(k) && IN((k) + 1))
    float* out = args.out;
    float* y = out;
    float* kwp = out + (size_t)MT * DM; float* vwp = kwp + (size_t)NB * WIN * 512;
    float* kws = vwp + (size_t)NB * WIN * 512; float* vws = kws + (size_t)DB * WIN * 512;
    float* sp = vws + (size_t)DB * WIN * 512; float* ss = sp + (size_t)NB * 4 * 128 * 128;
    const int gtid = F.vcu * (NWAVES * 64) + F.tid, gthreads = F.G * NWAVES * 64;
    const unsigned BG_P1_ITEMS = MK_BG_COPY ? (unsigned)((MT / 256) * (DIN / 256) / F.G) * 32u * (unsigned)F.G * 8u * MK_BG_COPY : 0u;
    const unsigned BG_P5_ITEMS = MK_BG_COPY5 ? (unsigned)((MT / 256) * (DM / 256) / F.G) * 32u * (unsigned)F.G * 8u * MK_BG_COPY5 : 0u;

    if (IN(0)) { p0_prologue(F, args); if (BOTH(0)) xcd_barrier(bar); }
    if (IN(1)) {
        pg8::Gemm g{(const pg8::bf16_t*)(ws + WS_XB), (const pg8::bf16_t*)(ws + WS_WTIN), MT, DIN, DM};
        pg8::StaticOrder S; S.init(MT, DIN, F.G, (int)blockIdx.x);
        pg8::EpiInProj E{ws, out, 0};
#if MK_BG_COPY
        pg8::CopyBg<MK_BG_COPY> bg; bg.init(args.in[2], args.in[3], kws, vws, 0u, F.G, (int)blockIdx.x, F.wave, F.lane);
        pg8::gemm_phase<pg8::EpiInProj, pg8::StaticOrder, PG8_ALIGN, PG8_SP2, pg8::CopyBg<MK_BG_COPY>>(F.lds + RING_OFF, g, S, E, bg);
#else
        pg8::NoBg bg;
        pg8::gemm_phase<pg8::EpiInProj, pg8::StaticOrder, PG8_ALIGN, PG8_SP2>(F.lds + RING_OFF, g, S, E, bg);
#endif
        if (BOTH(1)) xcd_barrier(bar);
    }
    const attn::Tensors AT{(const bf16*)(ws + WS_QA), (const bf16*)(ws + WS_KA), (const bf16*)(ws + WS_VA), (bf16*)(ws + WS_OP), (float*)(ws + WS_LSE), (const float*)(ws + WS_BIAST)};
    const hg::Tensors HT{(const float*)(ws + WS_GF), (const bf16*)(ws + WS_QB), (const bf16*)(ws + WS_VB), (const bf16*)(ws + WS_GB), args.in[9], (bf16*)(ws + WS_MIX),
                         (float*)(ws + WS_HL), (float*)(ws + WS_HD), (float*)(ws + WS_HS)};
    const sa::Tensors ST{args.in[2], args.in[3], (const bf16*)(ws + WS_QA), (const bf16*)(ws + WS_KA), (const bf16*)(ws + WS_VA), (const float*)(ws + WS_BS), (float*)(ws + WS_SPART)};
    if (IN(2)) {
        for (int rep = 0; rep < MK_REP_SATTN; ++rep) sa::fused_phase(F.lds, ST, kws, vws, (float*)(ws + WS_DUMMY), F.vcu, F.G, F.tid);
        for (int rep = 0; rep < MK_REP_H; ++rep) { hg::sample_phase(F.lds, HT, args.in[4], ss, F.vcu, F.G, F.tid); hg::phase<0>(F.lds, HT, F.vcu, F.G, F.tid); }
        for (int rep = 0; rep < MK_REP_ATTN; ++rep) attn::phase(F.lds, AT, F.vcu, F.G, F.tid);
        if (BOTH(2)) xcd_barrier(bar);
    }
    if (IN(3)) {
        hg::carry(HT, sp, gtid, gthreads);
        attn::combine(AT, (const bf16*)(ws + WS_GA), (bf16*)(ws + WS_MIX), gtid, gthreads);
        sa::combine(ST, (const bf16*)(ws + WS_GA), (bf16*)(ws + WS_MIX), gtid, gthreads);
        if (BOTH(3)) xcd_barrier(bar);
    }
    if (IN(4)) { hg::phase<1>(F.lds, HT, F.vcu, F.G, F.tid); if (BOTH(4)) xcd_barrier(bar); }
    if (IN(5)) {
        pg8::Gemm g{(const pg8::bf16_t*)(ws + WS_MIX), (const pg8::bf16_t*)(ws + WS_WTOUT), MT, DM, DM};
        pg8::StaticOrder S; S.init(MT, DM, F.G, (int)blockIdx.x);
        pg8::EpiZ E{args.in[0], args.in[1], y};
#if MK_BG_COPY5
        pg8::CopyBg<MK_BG_COPY5> bg; bg.init(args.in[2], args.in[3], kws, vws, BG_P1_ITEMS, F.G, (int)blockIdx.x, F.wave, F.lane);
        pg8::gemm_phase<pg8::EpiZ, pg8::StaticOrder, PG8_ALIGN, PG8_SP2, pg8::CopyBg<MK_BG_COPY5>>(F.lds + RING_OFF, g, S, E, bg);
#else
        pg8::NoBg bg;
        pg8::gemm_phase<pg8::EpiZ, pg8::StaticOrder, PG8_ALIGN, PG8_SP2>(F.lds + RING_OFF, g, S, E, bg);
#endif
        if (BOTH(5)) xcd_barrier(bar);
    }
    if (IN(6)) {
        const int gw = F.vcu * NWAVES + F.wave, NGW = F.G * NWAVES;
        for (int m = gw; m < MT; m += NGW) ln_row_inplace(y + (size_t)m * DM, args.in[10], args.in[11], F.lane);
    }
#undef IN
#undef BOTH
}

extern "C" void kernel_launch(void* const* d_in, const int* in_sizes, int n_in, void* d_out, int out_size, void* d_ws, size_t ws_size, hipStream_t stream) {
    static int grid = 0;
    if (grid == 0) {
        if (n_in != 12 || ws_size < WS_END) { fprintf(stderr, "kernel_launch: unexpected n_in %d / ws %zu\n", n_in, ws_size); grid = -1; return; }
        int dev = 0, cus = 0;
        if (hipGetDevice(&dev) != hipSuccess || hipDeviceGetAttribute(&cus, hipDeviceAttributeMultiprocessorCount, dev) != hipSuccess) { grid = -1; return; }
        if (hipFuncSetAttribute((const void*)mk, hipFuncAttributeMaxDynamicSharedMemorySize, LDS_BYTES) != hipSuccess) { grid = -1; return; }
        (void)hipGetLastError();
        grid = cus;
    }
    if (grid < 0) return;
    (void)hipMemsetAsync((char*)d_ws + WS_CTL, 0, CTL_ZERO_BYTES, stream);
    Args a{};
    for (int i = 0; i < 12; ++i) a.in[i] = (const float*)d_in[i];
    a.out = (float*)d_out; a.ws = (unsigned char*)d_ws; a.dbg_h32 = 0; a.pad = 0;
#if MK_N_LAUNCHES == 1
    a.ph_lo = 0; a.ph_hi = NPH;
    hipLaunchKernelGGL(mk, dim3(grid), dim3(NWAVES * 64), LDS_BYTES, stream, a);
#else
    for (int p = 0; p < NPH; ++p) { a.ph_lo = p; a.ph_hi = p + 1; hipLaunchKernelGGL(mk, dim3(grid), dim3(NWAVES * 64), LDS_BYTES, stream, a); }
#endif
}
```
